# Optimizing an MI355X kernel written in HIP

```python
import jax, jax.numpy as jnp
from jax import lax
import numpy as np

D_MODEL = 1024
BATCH = 16
SEQ = 4096
DEPTH = 4

CHUNK = 64
Q_BLOCK = 128
FOX_HEADS = D_MODEL // 128
FOX_HD = 64
FOX_W = FOX_HEADS * FOX_HD
ML_HEADS = 4
ML_HD = D_MODEL // 8
ML_W = ML_HEADS * ML_HD
CONV_K = 4
N_MEM = 256
X_HEADS = 4
X_HD = D_MODEL // X_HEADS
D_FF = 4 * D_MODEL
N_BRANCH = 2
EPS = 1e-6
SPLIT_SIZES = (FOX_W, FOX_W, FOX_W, FOX_HEADS,
               2 * ML_W, ML_W, ML_W, ML_HEADS, ML_HEADS,
               N_BRANCH * D_MODEL)
IN_WIDTH = sum(SPLIT_SIZES)
SPLIT_POINTS = tuple(int(s) for s in np.cumsum(SPLIT_SIZES)[:-1])

kernel_name = "hybrid_fox_mlstm_gated_trunk"


def rms_norm(x, g):
    xf = x.astype(jnp.float32)
    y = xf * lax.rsqrt(jnp.mean(xf * xf, axis=-1, keepdims=True) + EPS)
    return (y * g.astype(jnp.float32)).astype(x.dtype)


def causal_conv(u, w, b):
    S = u.shape[1]
    up = jnp.pad(u, ((0, 0), (CONV_K - 1, 0), (0, 0)))
    out = b
    for j in range(CONV_K):
        out = out + w[j] * up[:, j:j + S]
    return out


def fox_attention(q, k, v, fpre):
    B, S, H, d = q.shape
    nq = S // Q_BLOCK
    f32 = jnp.float32
    qf = q.astype(f32).transpose(0, 2, 1, 3) * (d ** -0.5)
    kf = k.astype(f32).transpose(0, 2, 1, 3)
    vf = v.astype(f32).transpose(0, 2, 1, 3)
    c = jnp.cumsum(jax.nn.log_sigmoid(fpre.astype(f32)), axis=1).transpose(0, 2, 1)
    qb = qf.reshape(B, H, nq, Q_BLOCK, d).transpose(2, 0, 1, 3, 4)
    cb = c.reshape(B, H, nq, Q_BLOCK).transpose(2, 0, 1, 3)
    kpos = jnp.arange(S)

    def block(args):
        qi, ci, i = args
        qpos = i * Q_BLOCK + jnp.arange(Q_BLOCK)
        logits = jnp.einsum('bhqd,bhkd->bhqk', qi, kf) + ci[..., :, None] - c[..., None, :]
        logits = jnp.where(kpos[None, :] <= qpos[:, None], logits, -jnp.inf)
        p = jax.nn.softmax(logits, axis=-1)
        return jnp.einsum('bhqk,bhkd->bhqd', p, vf)

    o = lax.map(block, (qb, cb, jnp.arange(nq)))
    return o.transpose(1, 0, 3, 2, 4).reshape(B, S, H * d)


def mlstm_chunkwise(q, k, v, ipre, fpre):
    B, S, H, d = q.shape
    L = CHUNK
    nc = S // L
    f32 = jnp.float32
    def chunked(t):
        return t.astype(f32).transpose(0, 2, 1, 3).reshape(B, H, nc, L, d)
    qc, kc, vc = chunked(q), chunked(k) * (d ** -0.5), chunked(v)
    ig = ipre.astype(f32).transpose(0, 2, 1).reshape(B, H, nc, L)
    logf = jax.nn.log_sigmoid(fpre.astype(f32)).transpose(0, 2, 1).reshape(B, H, nc, L)
    bcum = jnp.cumsum(logf, axis=-1)
    bL = bcum[..., -1]
    a = bL[..., None] - bcum + ig
    m_loc = jnp.max(a, axis=-1)
    wloc = jnp.exp(a - m_loc[..., None])
    C_loc = jnp.einsum('bhcl,bhcld,bhcle->bhcde', wloc, kc, vc)
    n_loc = jnp.einsum('bhcl,bhcld->bhcd', wloc, kc)

    def step(carry, xs):
        C, n, m = carry
        bl, ml, Cl, nl = xs
        m_new = jnp.maximum(bl + m, ml)
        s_old = jnp.exp(bl + m - m_new)
        s_loc = jnp.exp(ml - m_new)
        C_new = s_old[..., None, None] * C + s_loc[..., None, None] * Cl
        n_new = s_old[..., None] * n + s_loc[..., None] * nl
        return (C_new, n_new, m_new), (C, n, m)

    init = (jnp.zeros((B, H, d, d), f32), jnp.zeros((B, H, d), f32), jnp.zeros((B, H), f32))
    xs = (jnp.moveaxis(bL, 2, 0), jnp.moveaxis(m_loc, 2, 0),
          jnp.moveaxis(C_loc, 2, 0), jnp.moveaxis(n_loc, 2, 0))
    _, (C_prev, n_prev, m_prev) = lax.scan(step, init, xs)
    C_prev = jnp.moveaxis(C_prev, 0, 2)
    n_prev = jnp.moveaxis(n_prev, 0, 2)
    m_prev = jnp.moveaxis(m_prev, 0, 2)

    tri = jnp.tril(jnp.ones((L, L), dtype=bool))
    Dlog = bcum[..., :, None] - bcum[..., None, :] + ig[..., None, :]
    Dlog = jnp.where(tri, Dlog, -jnp.inf)
    inter_log = bcum + m_prev[..., None]
    m_t = jnp.maximum(inter_log, jnp.max(Dlog, axis=-1))
    Dw = jnp.exp(Dlog - m_t[..., None])
    inter_w = jnp.exp(inter_log - m_t)
    sqk = jnp.einsum('bhcld,bhcsd->bhcls', qc, kc) * Dw
    num = inter_w[..., None] * jnp.einsum('bhcld,bhcde->bhcle', qc, C_prev) \
        + jnp.einsum('bhcls,bhcse->bhcle', sqk, vc)
    den = inter_w * jnp.einsum('bhcld,bhcd->bhcl', qc, n_prev) + jnp.sum(sqk, axis=-1)
    h = num / jnp.maximum(jnp.abs(den), jnp.exp(-m_t))[..., None]
    return h.reshape(B, H, S, d).transpose(0, 2, 1, 3)


def cross_attention(hn, memn, wq, wkv, wo):
    B, S, _ = hn.shape
    q = (hn @ wq).reshape(B, S, X_HEADS, X_HD)
    kv = memn @ wkv
    k, v = jnp.split(kv, 2, axis=-1)
    k = k.reshape(B, -1, X_HEADS, X_HD)
    v = v.reshape(B, -1, X_HEADS, X_HD)
    logits = jnp.einsum('bqhd,bkhd->bhqk', q, k).astype(jnp.float32) * (X_HD ** -0.5)
    p = jax.nn.softmax(logits, axis=-1).astype(v.dtype)
    o = jnp.einsum('bhqk,bkhd->bqhd', p, v).reshape(B, S, D_MODEL)
    return o @ wo


def setup_inputs(seed: int = 0) -> dict:
    key = jax.random.key(seed)
    ks = jax.random.split(key, 32)
    f32 = jnp.float32
    def nrm(k, shape, fan_in):
        return jax.random.normal(k, shape, f32) * (fan_in ** -0.5)
    def gain(k, shape):
        return 1.0 + 0.02 * jax.random.normal(k, shape, f32)
    return {
        "x": jax.random.normal(ks[0], (BATCH, SEQ, D_MODEL), f32),
        "mem": jax.random.normal(ks[1], (BATCH, N_MEM, D_MODEL), f32),
        "norm_mix": gain(ks[2], (DEPTH, D_MODEL)),
        "norm_xattn": gain(ks[3], (DEPTH, D_MODEL)),
        "norm_mem": gain(ks[4], (DEPTH, D_MODEL)),
        "norm_mlp": gain(ks[5], (DEPTH, D_MODEL)),
        "w_in": nrm(ks[6], (DEPTH, D_MODEL, IN_WIDTH), D_MODEL),
        "b_fox_f": jax.random.uniform(ks[7], (DEPTH, FOX_HEADS), f32, 2.0, 5.0),
        "b_mlstm_i": 0.1 * jax.random.normal(ks[8], (DEPTH, ML_HEADS), f32),
        "b_mlstm_f": jax.random.uniform(ks[9], (DEPTH, ML_HEADS), f32, 3.0, 6.0),
        "b_gate": 0.01 * jax.random.normal(ks[10], (DEPTH, N_BRANCH * D_MODEL), f32),
        "conv_w": nrm(ks[11], (DEPTH, CONV_K, 2 * ML_W), CONV_K),
        "conv_b": 0.01 * jax.random.normal(ks[12], (DEPTH, 2 * ML_W), f32),
        "mlstm_norm": gain(ks[13], (DEPTH, ML_W)),
        "w_up_fox": nrm(ks[14], (DEPTH, FOX_W, D_MODEL), FOX_W),
        "w_up_mlstm": nrm(ks[15], (DEPTH, ML_W, D_MODEL), ML_W),
        "w_mix_out": nrm(ks[16], (DEPTH, D_MODEL, D_MODEL), D_MODEL),
        "w_xq": nrm(ks[17], (DEPTH, D_MODEL, D_MODEL), D_MODEL),
        "w_xkv": nrm(ks[18], (DEPTH, D_MODEL, 2 * D_MODEL), D_MODEL),
        "w_xo": nrm(ks[19], (DEPTH, D_MODEL, D_MODEL), D_MODEL),
        "w_mlp_in": nrm(ks[20], (DEPTH, D_MODEL, D_FF), D_MODEL),
        "w_mlp_out": nrm(ks[21], (DEPTH, D_FF, D_MODEL), D_FF),
        "norm_final": gain(ks[22], (D_MODEL,)),
    }


def reference(x, mem, norm_mix, norm_xattn, norm_mem, norm_mlp, w_in, b_fox_f, b_mlstm_i,
              b_mlstm_f, b_gate, conv_w, conv_b, mlstm_norm, w_up_fox, w_up_mlstm, w_mix_out,
              w_xq, w_xkv, w_xo, w_mlp_in, w_mlp_out, norm_final):
    B, S, _ = x.shape
    h = x
    for l in range(DEPTH):
        xn = rms_norm(h, norm_mix[l])
        proj = xn @ w_in[l]
        fq, fk, fv, ff, mqk, mv, mo, mi, mf, gpre = jnp.split(proj, SPLIT_POINTS, axis=-1)
        y_fox = fox_attention(fq.reshape(B, S, FOX_HEADS, FOX_HD),
                              fk.reshape(B, S, FOX_HEADS, FOX_HD),
                              fv.reshape(B, S, FOX_HEADS, FOX_HD),
                              ff + b_fox_f[l]).astype(h.dtype)
        qk = jax.nn.silu(causal_conv(mqk, conv_w[l], conv_b[l]))
        mq, mk = jnp.split(qk, 2, axis=-1)
        hm = mlstm_chunkwise(mq.reshape(B, S, ML_HEADS, ML_HD),
                             mk.reshape(B, S, ML_HEADS, ML_HD),
                             mv.reshape(B, S, ML_HEADS, ML_HD),
                             mi + b_mlstm_i[l], mf + b_mlstm_f[l])
        hm = hm * lax.rsqrt(jnp.mean(hm * hm, axis=-1, keepdims=True) + EPS)
        hm = hm.reshape(B, S, ML_W) * mlstm_norm[l].astype(jnp.float32)
        y_ml = (hm * jax.nn.sigmoid(mo.astype(jnp.float32))).astype(h.dtype)
        g = jax.nn.sigmoid(gpre + b_gate[l])
        g_fox, g_ml = jnp.split(g, 2, axis=-1)
        merged = g_fox * (y_fox @ w_up_fox[l]) + g_ml * (y_ml @ w_up_mlstm[l])
        h = h + merged @ w_mix_out[l]
        hn = rms_norm(h, norm_xattn[l])
        memn = rms_norm(mem, norm_mem[l])
        h = h + cross_attention(hn, memn, w_xq[l], w_xkv[l], w_xo[l])
        hn = rms_norm(h, norm_mlp[l])
        a = jax.nn.relu(hn @ w_mlp_in[l])
        h = h + (a * a) @ w_mlp_out[l]
    return rms_norm(h, norm_final)
```

```cpp
#include <hip/hip_runtime.h>
#include <cstdio>
#include <cstdint>
#include <cmath>
#define MK_PER_PHASE 1
namespace pg8 {
#define PG8_LAS __attribute__((address_space(3)))
typedef unsigned short bf16_t;
typedef short bf16x8 __attribute__((ext_vector_type(8)));
typedef float f32x4 __attribute__((ext_vector_type(4)));
typedef unsigned u32x4 __attribute__((ext_vector_type(4)));
constexpr int BM = 256, BK = 64, HALF = 128, HTB = HALF * BK * 2  , STAGE_BYTES = 8 * HTB, NXCD = 8, WGM = 8;

__host__ __device__ __forceinline__ int lds_byte(int r, int c) { const int st = (r >> 4) * 2 + (c >> 5), rr = r & 15, cc = c & 31, ob = rr * 64 + cc * 2; return st * 1024 + (ob ^ (((ob >> 9) & 1) << 5)); }
__host__ __device__ __forceinline__ void stage_rc(int b, int& R, int& C) { const int st = b / 1024, sb = b % 1024, swz = sb ^ (((sb >> 9) & 1) << 5); R = (st >> 1) * 16 + swz / 64; C = (st & 1) * 32 + (swz % 64) / 2; }
__host__ __device__ __forceinline__ int perm32(int rho) { const int n = rho >> 4, i = rho & 15; return 8 * (i >> 2) + 4 * n + (i & 3); }

struct Unit { int pm, pn; };
struct Gemm { const bf16_t* A; const bf16_t* Bt; int M, N, K; };

struct StaticOrder {
    int nM, nN, nwg, G, c;
    __host__ __device__ void init(int M, int N, int G_, int c_) { nM = M / BM; nN = N / BM; nwg = nM * nN; G = G_; c = c_; }
    __host__ __device__ bool next(int i, Unit& u) const {
        const long L = (long)i * G + c; if (L >= nwg) return false;
        int wgid = (int)L; { const int q = nwg / NXCD, r = nwg % NXCD, xcd = wgid % NXCD, off = wgid / NXCD; wgid = (xcd < r ? xcd * (q + 1) : r * (q + 1) + (xcd - r) * q) + off; }
        const int nig = WGM * nN, gid = wgid / nig, fm = gid * WGM, gsz = (nM - fm) < WGM ? (nM - fm) : WGM;
        u.pm = fm + ((wgid % nig) % gsz); u.pn = (wgid % nig) / gsz; return true;
    }
    __device__ __forceinline__ void a_ready(const Unit&) const {}
    __device__ __forceinline__ void done(const Unit&) const {}
};

__device__ __forceinline__ unsigned cvt_pk_bf16(float lo, float hi) { unsigned r; asm volatile("v_cvt_pk_bf16_f32 %0, %1, %2" : "=v"(r) : "v"(lo), "v"(hi)); return r; }
typedef float f32x2 __attribute__((ext_vector_type(2)));
__device__ __forceinline__ float bf2f(unsigned short b) { return __uint_as_float((unsigned)b << 16); }
__device__ __forceinline__ float fsigm(float x) { return 1.0f / (1.0f + __expf(-x)); }
__device__ __forceinline__ f32x4 sigm4(f32x4 v) { return (f32x4){fsigm(v[0]), fsigm(v[1]), fsigm(v[2]), fsigm(v[3])}; }
__device__ __forceinline__ void unpack8(const u32x4 w, f32x4& a, f32x4& b) {
    a = (f32x4){__uint_as_float(w.x << 16), __uint_as_float(w.x & 0xffff0000u), __uint_as_float(w.y << 16), __uint_as_float(w.y & 0xffff0000u)};
    b = (f32x4){__uint_as_float(w.z << 16), __uint_as_float(w.z & 0xffff0000u), __uint_as_float(w.w << 16), __uint_as_float(w.w & 0xffff0000u)};
}
template <int MODE> struct EpiB {
    static constexpr bool PERM = true, AFTER_DRAIN = false;
    bf16_t* O; int ldc; const float* bias; const bf16_t* G; const bf16_t* T;
    __device__ __forceinline__ void operator()(const f32x4 (&acc)[2][2][4][2], const Unit& u, int wr, int wc, int fr, int fq) const {
        bf16_t* base = O; int ld = ldc; int colt = u.pn * BM;
        if (MODE == 5) {
            const int pn = u.pn; int slot;
            if (pn < 6) { slot = pn >> 1; ld = 512; colt = (pn & 1) * 256; }
            else if (pn < 10) { slot = 3; ld = 1024; colt = (pn - 6) * 256; }
            else { slot = 5 + ((pn - 10) >> 1); ld = 512; colt = ((pn - 10) & 1) * 256; }
            base = O + (size_t)slot * 33554432u;
        }
        const int row0 = u.pm * BM + wr * 64 + fr;
        const int col0 = colt + wc * 32 + 8 * fq, bcol0 = u.pn * BM + wc * 32 + 8 * fq;
        f32x4 bv[2][2];
#pragma unroll
        for (int bj = 0; bj < 2; ++bj)
#pragma unroll
            for (int n = 0; n < 2; ++n) bv[bj][n] = (MODE == 1) ? *(const f32x4*)(bias + bcol0 + bj * HALF + 4 * n) : (f32x4){0.f, 0.f, 0.f, 0.f};
#pragma unroll
        for (int ai = 0; ai < 2; ++ai)
#pragma unroll
            for (int m = 0; m < 4; ++m) { const size_t roff = (size_t)(row0 + ai * HALF + m * 16) * ld + col0;
#pragma unroll
                for (int bj = 0; bj < 2; ++bj) { f32x4 v0 = acc[ai][bj][m][0], v1 = acc[ai][bj][m][1];
                    if (MODE == 1) { v0 = sigm4(v0 + bv[bj][0]); v1 = sigm4(v1 + bv[bj][1]); }
                    if (MODE == 2 || MODE == 3) { f32x4 g0, g1; unpack8(*(const u32x4*)(G + roff + bj * HALF), g0, g1); v0 = v0 * g0; v1 = v1 * g1; }
                    if (MODE == 3) { f32x4 t0, t1; unpack8(*(const u32x4*)(T + roff + bj * HALF), t0, t1); v0 = v0 + t0; v1 = v1 + t1; }
                    if (MODE == 4) { v0 = __builtin_elementwise_max(v0, (f32x4){0.f, 0.f, 0.f, 0.f}); v1 = __builtin_elementwise_max(v1, (f32x4){0.f, 0.f, 0.f, 0.f}); v0 = v0 * v0; v1 = v1 * v1; }
                    u32x4 w; w.x = cvt_pk_bf16(v0[0], v0[1]); w.y = cvt_pk_bf16(v0[2], v0[3]); w.z = cvt_pk_bf16(v1[0], v1[1]); w.w = cvt_pk_bf16(v1[2], v1[3]);
                    *(u32x4*)(base + roff + bj * HALF) = w; }
                if (MODE == 2 || MODE == 3) asm volatile("" ::: "memory"); }
    }
};
struct EpiResid {
    static constexpr bool PERM = false, AFTER_DRAIN = false;
    const float* hin; float* out; int ldc;
    __device__ __forceinline__ void operator()(const f32x4 (&acc)[2][2][4][2], const Unit& u, int wr, int wc, int fr, int fq) const {
        const int row0 = u.pm * BM + wr * 64 + fr, col0 = u.pn * BM + wc * 32 + 4 * fq;
#pragma unroll
        for (int ai = 0; ai < 2; ++ai)
#pragma unroll
            for (int m = 0; m < 4; ++m) { const size_t off = (size_t)(row0 + ai * HALF + m * 16) * ldc + col0;
                f32x4 r[2][2];
#pragma unroll
                for (int bj = 0; bj < 2; ++bj)
#pragma unroll
                    for (int n = 0; n < 2; ++n) r[bj][n] = *(const f32x4*)(hin + off + bj * HALF + n * 16);
#pragma unroll
                for (int bj = 0; bj < 2; ++bj)
#pragma unroll
                    for (int n = 0; n < 2; ++n) *(f32x4*)(out + off + bj * HALF + n * 16) = r[bj][n] + acc[ai][bj][m][n];
                asm volatile("" ::: "memory"); }
    }
};
template <class Epi, class Sched, bool ALIGN_EPI = false, bool SP2 = false>
__device__ __forceinline__ void gemm_phase(PG8_LAS unsigned char* lds, const Gemm g, const Sched& S, const Epi& E) {
    int tid_ = threadIdx.x; asm volatile("" : "+v"(tid_));
    const int tid = tid_, wid = __builtin_amdgcn_readfirstlane(tid >> 6), lane = tid & 63, wr = wid >> 2, wc = wid & 3, fr = lane & 15, fq = lane >> 4;
    const int K = g.K, nt = K / BK;
    unsigned voffA[2], voffB[2];
#pragma unroll
    for (int i = 0; i < 2; ++i) { int R, C; stage_rc(tid * 16 + i * 8192, R, C); const int Rb = Epi::PERM ? ((R & ~31) + perm32(R & 31)) : R;
        voffA[i] = (unsigned)(R * K + C) * 2u; voffB[i] = (unsigned)(Rb * K + C) * 2u; }
    const size_t kstep = (size_t)(BK * 2);
    const size_t hstep = (size_t)HALF * K * 2;
    const size_t tstep = 2 * hstep;
    const unsigned ldsw = (unsigned)wid * 1024u;
    const int aoff = lds_byte(wr * 64 + fr, fq * 8), boff = lds_byte(wc * 32 + fr, fq * 8);
#define PG8_SA(b, h) (((b) * 2 + (h)) * HTB)
#define PG8_SB(b, h) ((4 + (b) * 2 + (h)) * HTB)
#define PG8_STAGE(bufoff, gbase, voff) do { _Pragma("unroll") for (int _i = 0; _i < 2; ++_i) \
        __builtin_amdgcn_global_load_lds((const unsigned*)((const char*)(gbase) + (voff)[_i]), (PG8_LAS unsigned*)(lds + (bufoff) + ldsw + _i * 8192), 16, 0, 0); } while (0)
#define PG8_LDA(dst, b, h) do { _Pragma("unroll") for (int m = 0; m < 4; ++m) _Pragma("unroll") for (int k = 0; k < 2; ++k) dst[m][k] = *(const PG8_LAS bf16x8*)(lds + PG8_SA(b, h) + aoff + m * 2048 + k * 1024); } while (0)
#define PG8_LDB(dst, b, h) do { _Pragma("unroll") for (int n = 0; n < 2; ++n) _Pragma("unroll") for (int k = 0; k < 2; ++k) dst[n][k] = *(const PG8_LAS bf16x8*)(lds + PG8_SB(b, h) + boff + n * 2048 + k * 1024); } while (0)
#define PG8_MMA(ai, bj, At, Bt) do { __builtin_amdgcn_s_setprio(1); _Pragma("unroll") for (int m = 0; m < 4; ++m) _Pragma("unroll") for (int n = 0; n < 2; ++n) _Pragma("unroll") for (int k = 0; k < 2; ++k) \
        acc[ai][bj][m][n] = __builtin_amdgcn_mfma_f32_16x16x32_bf16(Bt[n][k], At[m][k], acc[ai][bj][m][n], 0, 0, 0); __builtin_amdgcn_s_setprio(0); } while (0)
#define PG8_WAIT_V(n) asm volatile("s_waitcnt vmcnt(" #n ")" ::: "memory")
#define PG8_WAIT_L(n) asm volatile("s_waitcnt lgkmcnt(" #n ")" ::: "memory")
#define PG8_BAR __builtin_amdgcn_s_barrier()
#define PG8_SCHED __builtin_amdgcn_sched_barrier(0)
    Unit cur, nxt; int ui = 0;
    if (!S.next(0, cur)) return;
    f32x4 acc[2][2][4][2];
#pragma unroll
    for (int a = 0; a < 2; ++a)
#pragma unroll
        for (int b = 0; b < 2; ++b)
#pragma unroll
            for (int m = 0; m < 4; ++m)
#pragma unroll
                for (int n = 0; n < 2; ++n) acc[a][b][m][n] = (f32x4){0.f, 0.f, 0.f, 0.f};
    bf16x8 At[4][2], B0[2][2], B1[2][2];
    const char* cA = (const char*)g.A + (size_t)cur.pm * tstep; const char* cB = (const char*)g.Bt + (size_t)cur.pn * tstep;
    S.a_ready(cur);
    if constexpr (SP2) {
        PG8_STAGE(PG8_SB(0, 0), cB, voffB); PG8_STAGE(PG8_SB(0, 1), cB + hstep, voffB); PG8_STAGE(PG8_SA(0, 0), cA, voffA); PG8_STAGE(PG8_SA(0, 1), cA + hstep, voffA);
        if (wr == 1) PG8_BAR;
        PG8_WAIT_V(2); PG8_BAR;
        PG8_STAGE(PG8_SB(1, 0), cB + kstep, voffB); PG8_STAGE(PG8_SA(1, 0), cA + kstep, voffA); PG8_STAGE(PG8_SB(1, 1), cB + hstep + kstep, voffB);
        PG8_WAIT_V(6); PG8_BAR;
    } else {
        PG8_STAGE(PG8_SB(0, 0), cB, voffB); PG8_STAGE(PG8_SA(0, 0), cA, voffA); PG8_STAGE(PG8_SB(0, 1), cB + hstep, voffB); PG8_STAGE(PG8_SA(0, 1), cA + hstep, voffA);
        if (wr == 1) PG8_BAR;
        PG8_WAIT_V(4); PG8_BAR;
        PG8_STAGE(PG8_SB(1, 0), cB + kstep, voffB); PG8_STAGE(PG8_SA(1, 0), cA + kstep, voffA); PG8_STAGE(PG8_SB(1, 1), cB + hstep + kstep, voffB);
        PG8_WAIT_V(6); PG8_BAR;
    }
    for (;;) {
        const bool has_next = S.next(ui + 1, nxt);
        const char* nA = has_next ? (const char*)g.A + (size_t)nxt.pm * tstep : cA; const char* nB = has_next ? (const char*)g.Bt + (size_t)nxt.pn * tstep : cB;
        for (int t = 0; t < nt; t += 2) {
            const bool last = (t == nt - 2);
            const char* a1 = cA + (size_t)(t + 1) * kstep;
            const char* a2 = last ? nA : cA + (size_t)(t + 2) * kstep; const char* b2 = last ? nB : cB + (size_t)(t + 2) * kstep;
            const char* a3 = a2 + kstep; const char* b3 = b2 + kstep;
            if (last && has_next) S.a_ready(nxt);
            if constexpr (SP2) {
            PG8_LDB(B0, 0, 0); PG8_LDB(B1, 0, 1); PG8_SCHED; PG8_LDA(At, 0, 0); PG8_STAGE(PG8_SA(1, 1), a1 + hstep, voffA);
            PG8_WAIT_V(8); PG8_WAIT_L(0); PG8_BAR; PG8_MMA(0, 0, At, B0); PG8_MMA(0, 1, At, B1); PG8_BAR; PG8_SCHED;
            PG8_LDA(At, 0, 1); PG8_STAGE(PG8_SB(0, 0), b2, voffB); PG8_STAGE(PG8_SB(0, 1), b2 + hstep, voffB); PG8_STAGE(PG8_SA(0, 0), a2, voffA);
            PG8_WAIT_V(8); PG8_WAIT_L(0); PG8_BAR; PG8_MMA(1, 0, At, B0); PG8_MMA(1, 1, At, B1); PG8_BAR; PG8_SCHED;
            PG8_LDB(B0, 1, 0); PG8_LDB(B1, 1, 1); PG8_SCHED; PG8_LDA(At, 1, 0); PG8_STAGE(PG8_SA(0, 1), a2 + hstep, voffA);
            PG8_WAIT_V(8); PG8_WAIT_L(0); PG8_BAR; PG8_MMA(0, 0, At, B0); PG8_MMA(0, 1, At, B1); PG8_BAR; PG8_SCHED;
            PG8_LDA(At, 1, 1); PG8_STAGE(PG8_SB(1, 0), b3, voffB); PG8_STAGE(PG8_SB(1, 1), b3 + hstep, voffB); PG8_STAGE(PG8_SA(1, 0), a3, voffA);
            PG8_WAIT_V(8); PG8_WAIT_L(0); PG8_BAR; PG8_MMA(1, 0, At, B0); PG8_MMA(1, 1, At, B1); PG8_BAR; PG8_SCHED;
            } else {
            PG8_LDB(B0, 0, 0); PG8_SCHED; PG8_LDA(At, 0, 0); PG8_STAGE(PG8_SA(1, 1), a1 + hstep, voffA);
            PG8_WAIT_L(8); PG8_BAR; PG8_WAIT_L(0); PG8_MMA(0, 0, At, B0); PG8_BAR; PG8_SCHED;
            PG8_LDB(B1, 0, 1); PG8_STAGE(PG8_SB(0, 0), b2, voffB);
            PG8_BAR; PG8_WAIT_L(0); PG8_MMA(0, 1, At, B1); PG8_BAR;
            PG8_LDA(At, 0, 1); PG8_STAGE(PG8_SA(0, 0), a2, voffA);
            PG8_BAR; PG8_WAIT_L(0); PG8_MMA(1, 0, At, B0); PG8_BAR; PG8_SCHED;
            PG8_STAGE(PG8_SB(0, 1), b2 + hstep, voffB);
            PG8_WAIT_V(6); PG8_BAR; PG8_MMA(1, 1, At, B1); PG8_BAR;
            PG8_LDB(B0, 1, 0); PG8_SCHED; PG8_LDA(At, 1, 0); PG8_STAGE(PG8_SA(0, 1), a2 + hstep, voffA);
            PG8_WAIT_L(8); PG8_BAR; PG8_WAIT_L(0); PG8_MMA(0, 0, At, B0); PG8_BAR; PG8_SCHED;
            PG8_LDB(B1, 1, 1); PG8_STAGE(PG8_SB(1, 0), b3, voffB);
            PG8_BAR; PG8_WAIT_L(0); PG8_MMA(0, 1, At, B1); PG8_BAR;
            PG8_LDA(At, 1, 1); PG8_STAGE(PG8_SA(1, 0), a3, voffA);
            PG8_BAR; PG8_WAIT_L(0); PG8_MMA(1, 0, At, B0); PG8_BAR; PG8_SCHED;
            PG8_STAGE(PG8_SB(1, 1), b3 + hstep, voffB);
            PG8_WAIT_V(6); PG8_BAR; PG8_MMA(1, 1, At, B1); PG8_BAR;
            }
        }
        if constexpr (ALIGN_EPI) { if (wr == 0) PG8_BAR; }
        if constexpr (!Epi::AFTER_DRAIN) { E(acc, cur, wr, wc, fr, fq); S.done(cur); }
        if (!has_next) break;
#pragma unroll
        for (int a = 0; a < 2; ++a)
#pragma unroll
            for (int b = 0; b < 2; ++b)
#pragma unroll
                for (int m = 0; m < 4; ++m)
#pragma unroll
                    for (int n = 0; n < 2; ++n) acc[a][b][m][n] = (f32x4){0.f, 0.f, 0.f, 0.f};
        cur = nxt; cA = nA; cB = nB; ++ui;
        if constexpr (ALIGN_EPI) { if (wr == 1) PG8_BAR; }
    }
    PG8_WAIT_V(0);
    if constexpr (!ALIGN_EPI) { if (wr == 0) PG8_BAR; }
    PG8_BAR;
    if constexpr (Epi::AFTER_DRAIN) { E.fused(acc, cur, wr, wc, fr, fq, lds, wid, lane); S.done(cur); }
#undef PG8_SA
#undef PG8_SB
#undef PG8_STAGE
#undef PG8_LDA
#undef PG8_LDB
#undef PG8_MMA
#undef PG8_WAIT_V
#undef PG8_WAIT_L
#undef PG8_BAR
#undef PG8_SCHED
}
}
#define GAS __attribute__((address_space(1)))
#define LAS __attribute__((address_space(3)))
typedef unsigned short bf16;
typedef unsigned v4u __attribute__((ext_vector_type(4)));
typedef float f32x4 __attribute__((ext_vector_type(4)));
typedef short bf16x8 __attribute__((ext_vector_type(8)));
typedef GAS unsigned gu32;
typedef GAS unsigned long long gu64;
#define RLX_AGENT __ATOMIC_RELAXED, __HIP_MEMORY_SCOPE_AGENT
#define LDS_WAIT() asm volatile("s_waitcnt lgkmcnt(0)" ::: "memory")
#define VM_WAIT() asm volatile("s_waitcnt vmcnt(0)" ::: "memory")
__device__ __forceinline__ unsigned long long rt() { return __builtin_amdgcn_s_memrealtime(); }
__device__ __forceinline__ unsigned f2bf(float f) { unsigned u = __builtin_bit_cast(unsigned, f); return (u + 0x7fffu + ((u >> 16) & 1u)) >> 16; }
__device__ __forceinline__ unsigned pk2(float lo, float hi) { return f2bf(lo) | (f2bf(hi) << 16); }
#define XB_TMO      128
#define XB_XCNT(j)  (256  + 64 * (j))
#define XB_XSUB(j)  (1280 + 64 * (j))
#define XB_XGEN(j)  (2304 + 64 * (j))
#define XB_TOP      3328
#define XB_TOPGEN   3392
#define XCD_BAR_WORDS 3456
#define XB_SPIN_CAP (1u << 18)

__device__ __forceinline__ unsigned xb_ld(unsigned* p)              { return __hip_atomic_load(p, __ATOMIC_RELAXED, __HIP_MEMORY_SCOPE_AGENT); }
__device__ __forceinline__ unsigned xb_add(unsigned* p, unsigned v) { return __hip_atomic_fetch_add(p, v, __ATOMIC_RELAXED, __HIP_MEMORY_SCOPE_AGENT); }
__device__ __forceinline__ unsigned xb_xcc_id() { return (unsigned)__builtin_amdgcn_s_getreg((3 << 11) | 20) & 0xFu; }
#define XB_SPIN(cond, bar) do { unsigned _sp = 0; while (cond) { __builtin_amdgcn_s_sleep(1); \
    if ((++_sp & 255u) == 0u) { if (xb_ld(&(bar)[XB_TMO])) break; if (_sp > XB_SPIN_CAP) { atomicAdd(&(bar)[XB_TMO], 1u); break; } } } } while (0)

struct XcdBarrier {
    unsigned* bar; unsigned x;
    volatile LAS unsigned* st;
};

__device__ __forceinline__ XcdBarrier xcd_barrier_post(unsigned* bar, volatile LAS unsigned* st) {
    XcdBarrier b; b.bar = bar; b.x = xb_xcc_id(); b.st = st;
    if (threadIdx.x == 0) (void)xb_add(&bar[XB_XCNT(b.x)], 1u);
    return b;
}
__device__ __forceinline__ void xcd_barrier_complete(unsigned* bar, unsigned x, unsigned& nloc, unsigned& nx) {
    const unsigned G = gridDim.x * gridDim.y * gridDim.z;
    unsigned sum, cnt, mine, sp = 0u;
    for (;;) {
        sum = 0u; cnt = 0u; mine = 0u;
#pragma unroll
        for (unsigned j = 0; j < 16; ++j) { const unsigned c = xb_ld(&bar[XB_XCNT(j)]); sum += c; cnt += (c > 0u) ? 1u : 0u; mine = (j == x) ? c : mine; }
        if (sum == G) break;
        __builtin_amdgcn_s_sleep(1);
        if ((++sp & 255u) == 0u) { if (xb_ld(&bar[XB_TMO])) break; if (sp > XB_SPIN_CAP) { atomicAdd(&bar[XB_TMO], 1u); break; } }
    }
    nloc = mine > 0u ? mine : 1u; nx = cnt > 0u ? cnt : 1u;
}

__device__ __forceinline__ void xcd_barrier(const XcdBarrier& b) {
    asm volatile("s_waitcnt vmcnt(0)" ::: "memory");
    __syncthreads();
    if (threadIdx.x == 0) {
        unsigned* bar = b.bar;
        __builtin_amdgcn_s_waitcnt(0);
        unsigned nloc = b.st[0], nx = b.st[1];
        if (nloc == 0u) { xcd_barrier_complete(bar, b.x, nloc, nx); b.st[0] = nloc; b.st[1] = nx; }
        const unsigned old = xb_add(&bar[XB_XSUB(b.x)], 1u);
        const unsigned gen = old / nloc;
        if (old + 1u == (gen + 1u) * nloc) {
            __builtin_amdgcn_fence(__ATOMIC_RELEASE, "agent");
            asm volatile("s_waitcnt vmcnt(0)" ::: "memory");
            const unsigned og = xb_add(&bar[XB_TOP], 1u);
            const unsigned tg = og / nx;
            if (og + 1u == (tg + 1u) * nx) xb_add(&bar[XB_TOPGEN], 1u);
            else XB_SPIN(xb_ld(&bar[XB_TOPGEN]) == tg, bar);
            __builtin_amdgcn_fence(__ATOMIC_ACQUIRE, "agent");
            xb_add(&bar[XB_XGEN(b.x)], 1u);
            asm volatile("s_waitcnt vmcnt(0)" ::: "memory");
        } else {
            XB_SPIN(xb_ld(&bar[XB_XGEN(b.x)]) == gen, bar);
            __builtin_amdgcn_fence(__ATOMIC_ACQUIRE, "agent");
            asm volatile("s_waitcnt vmcnt(0)" ::: "memory");
        }
    }
    __syncthreads();
}
constexpr int NWAVES = 8;
constexpr int DM = 1024, NB = 16, SEQ = 4096, DEPTH = 4, M = NB * SEQ;
constexpr int NMEM = 256, MROWS = NB * NMEM;
constexpr int DFF = 4096, INW = 5648;
constexpr float EPS = 1e-6f, LOG2E = 1.4426950408889634f;
constexpr float FOX_QS = 0.125f * LOG2E;
constexpr float X_QS = 0.0625f * LOG2E;
constexpr float ML_KS = 0.08838834764831845f;

constexpr size_t MiB = 1u << 20;
constexpr size_t WS_CTL = 0, CTL_ZERO_BYTES = 1 * MiB;
constexpr size_t WS_FFL = 1 * MiB;
constexpr size_t WS_IG = 3 * MiB;
constexpr size_t WS_LF = 4 * MiB;
constexpr size_t WS_CN2 = 5 * MiB;
constexpr size_t WS_W = 16 * MiB, WL = 36 * MiB;
constexpr size_t WT_IN = 0, WT_GF = 7 * MiB, WT_GM = 9 * MiB, WT_UPF = 11 * MiB, WT_UPM = 12 * MiB, WT_MIX = 13 * MiB, WT_XQ = 15 * MiB, WT_XO = 17 * MiB,
                 WT_M1 = 19 * MiB, WT_M2 = 27 * MiB, WT_WG = 35 * MiB;
constexpr size_t WS_XK = 160 * MiB;
constexpr size_t WS_XVT = 192 * MiB;
constexpr size_t WS_XN = 224 * MiB;
constexpr size_t WS_BIG = 352 * MiB, SLOT = 64 * MiB;
constexpr size_t WS_END = WS_BIG + 8 * SLOT;
constexpr int CW_TMO = 0, CW_CODE = 1, CW_BAR = 4096;

constexpr int RING_OFF = 0, RING_BYTES = 131072;
constexpr int LDS_BYTES = 147456;
constexpr int LDSCTL_OFF = LDS_BYTES - 512, MISC_OFF = LDSCTL_OFF + 320;
struct Frame {
    LAS unsigned char* lds;
    volatile LAS unsigned* MISC;
    gu32* ctl;
    int tid, lane, wave;
    int vcu, G;
};
__device__ __forceinline__ float wave_sum(float v) {
#pragma unroll
    for (int o = 1; o < 64; o <<= 1) v += __shfl_xor(v, o);
    return v;
}
__device__ __forceinline__ float wave_max(float v) {
#pragma unroll
    for (int o = 1; o < 64; o <<= 1) v = fmaxf(v, __shfl_xor(v, o));
    return v;
}
__device__ __forceinline__ float bf2f(unsigned short b) { return __uint_as_float((unsigned)b << 16); }
__device__ __forceinline__ float logsigmoid(float x) { return fminf(x, 0.f) - log1pf(expf(-fabsf(x))); }
__device__ __forceinline__ void unpack8(const v4u w, float* f) {
    f[0] = __uint_as_float(w.x << 16); f[1] = __uint_as_float(w.x & 0xffff0000u); f[2] = __uint_as_float(w.y << 16); f[3] = __uint_as_float(w.y & 0xffff0000u);
    f[4] = __uint_as_float(w.z << 16); f[5] = __uint_as_float(w.z & 0xffff0000u); f[6] = __uint_as_float(w.w << 16); f[7] = __uint_as_float(w.w & 0xffff0000u);
}

__device__ __forceinline__ void transpose_item(const float* W, int ld, int c0, int ncols, int K, bf16* WT, float scale, LAS float* scr, int item, int lane) {
    const int nblk = ncols / 32, kb = item / nblk, nb = item % nblk, k0 = 64 * kb, n0 = 32 * nb;
#pragma unroll 8
    for (int i = 0; i < 32; ++i) { const int kk = 2 * i + (lane >> 5); scr[kk * 33 + (lane & 31)] = W[(size_t)(k0 + kk) * ld + c0 + n0 + (lane & 31)] * scale; }
    LDS_WAIT(); asm volatile("" ::: "memory");
    const int c = lane & 7;
#pragma unroll
    for (int j = 0; j < 4; ++j) { const int n = (lane >> 3) + 8 * j; const LAS float* s = scr + (8 * c) * 33 + n;
        v4u o; o.x = pk2(s[0 * 33], s[1 * 33]); o.y = pk2(s[2 * 33], s[3 * 33]); o.z = pk2(s[4 * 33], s[5 * 33]); o.w = pk2(s[6 * 33], s[7 * 33]);
        *(GAS v4u*)(WT + (size_t)(n0 + n) * K + k0 + 8 * c) = o; }
    LDS_WAIT(); asm volatile("" ::: "memory");
}
constexpr int ITEMS_PER_LAYER = 256 + 512 + 1024 + 512 + 512 + 256 + 256 + 512 + 512 + 512 + 512 + 512 + 2048 + 2048;
#define KAS __attribute__((address_space(4)))
__device__ __forceinline__ void p0_prologue(Frame& F, const KAS char* ka, unsigned char* ws) {
#define PIN(k) (*(const float* const KAS*)(ka + 8 * (k)))
    LAS float* scr = (LAS float*)(F.lds + RING_OFF + F.wave * 16384);
    const int gw = F.vcu * NWAVES + F.wave, NGW = F.G * NWAVES;
    for (int it = gw; it < DEPTH * ITEMS_PER_LAYER; it += NGW) {
        const int l = it / ITEMS_PER_LAYER; int r = it % ITEMS_PER_LAYER;
        unsigned char* wl = ws + WS_W + (size_t)l * WL;
        const float* w_in = PIN(6) + (size_t)l * DM * INW;
        bf16* wtin = (bf16*)(wl + WT_IN);
        if (r < 256) { transpose_item(w_in, INW, 0, 512, DM, wtin, FOX_QS, scr, r, F.lane); continue; } r -= 256;
        if (r < 512) { transpose_item(w_in, INW, 512, 1024, DM, wtin + (size_t)512 * DM, 1.f, scr, r, F.lane); continue; } r -= 512;
        if (r < 1024) { transpose_item(w_in, INW, 1544, 2048, DM, wtin + (size_t)1536 * DM, 1.f, scr, r, F.lane); continue; } r -= 1024;
        if (r < 512) { transpose_item(w_in, INW, 3600, 1024, DM, (bf16*)(wl + WT_GF), 1.f, scr, r, F.lane); continue; } r -= 512;
        if (r < 512) { transpose_item(w_in, INW, 4624, 1024, DM, (bf16*)(wl + WT_GM), 1.f, scr, r, F.lane); continue; } r -= 512;
        if (r < 256) { transpose_item(PIN(14) + (size_t)l * 512 * DM, DM, 0, DM, 512, (bf16*)(wl + WT_UPF), 1.f, scr, r, F.lane); continue; } r -= 256;
        if (r < 256) { transpose_item(PIN(15) + (size_t)l * 512 * DM, DM, 0, DM, 512, (bf16*)(wl + WT_UPM), 1.f, scr, r, F.lane); continue; } r -= 256;
        if (r < 512) { transpose_item(PIN(16) + (size_t)l * DM * DM, DM, 0, DM, DM, (bf16*)(wl + WT_MIX), 1.f, scr, r, F.lane); continue; } r -= 512;
        if (r < 512) { transpose_item(PIN(17) + (size_t)l * DM * DM, DM, 0, DM, DM, (bf16*)(wl + WT_XQ), X_QS, scr, r, F.lane); continue; } r -= 512;
        if (r < 512) { transpose_item(PIN(18) + (size_t)l * DM * 2 * DM, 2 * DM, 0, DM, DM, (bf16*)(ws + WS_BIG + (size_t)l * 4 * MiB), 1.f, scr, r, F.lane); continue; } r -= 512;
        if (r < 512) { transpose_item(PIN(18) + (size_t)l * DM * 2 * DM, 2 * DM, DM, DM, DM, (bf16*)(ws + WS_BIG + (size_t)l * 4 * MiB + 2 * MiB), 1.f, scr, r, F.lane); continue; } r -= 512;
        if (r < 512) { transpose_item(PIN(19) + (size_t)l * DM * DM, DM, 0, DM, DM, (bf16*)(wl + WT_XO), 1.f, scr, r, F.lane); continue; } r -= 512;
        if (r < 2048) { transpose_item(PIN(20) + (size_t)l * DM * DFF, DFF, 0, DFF, DM, (bf16*)(wl + WT_M1), 1.f, scr, r, F.lane); continue; } r -= 2048;
        transpose_item(PIN(21) + (size_t)l * DFF * DM, DM, 0, DM, DFF, (bf16*)(wl + WT_M2), 1.f, scr, r, F.lane);
    }
    for (int idx = (F.vcu * NWAVES + F.wave) * 64 + F.lane; idx < DEPTH * 16 * DM; idx += F.G * NWAVES * 64) {
        const int l = idx >> 14, c = (idx >> 10) & 15, k = idx & 1023;
        const int col = c < 8 ? 1536 + c : (c < 12 ? 3592 + (c - 8) : 3596 + (c - 12));
        ((float*)(ws + WS_W + (size_t)l * WL + WT_WG))[c * DM + k] = PIN(6)[(size_t)l * DM * INW + (size_t)k * INW + col];
    }
    for (int m = gw; m < MROWS; m += NGW) {
        const GAS f32x4* xr = (const GAS f32x4*)(PIN(1) + (size_t)m * DM) + F.lane;
        f32x4 v[4]; float s2 = 0.f;
#pragma unroll
        for (int j = 0; j < 4; ++j) { v[j] = xr[64 * j]; s2 += (v[j].x * v[j].x + v[j].y * v[j].y) + (v[j].z * v[j].z + v[j].w * v[j].w); }
        const float r = 1.f / sqrtf(wave_sum(s2) * (1.f / DM) + EPS);
#pragma unroll
        for (int l = 0; l < DEPTH; ++l) {
            GAS unsigned long long* o8 = (GAS unsigned long long*)(ws + WS_BIG + 16 * MiB + (size_t)l * 8 * MiB + (size_t)m * DM * 2) + F.lane;
#pragma unroll
            for (int j = 0; j < 4; ++j) { const f32x4 g = ((const GAS f32x4*)(PIN(4) + (size_t)l * DM))[F.lane + 64 * j];
                o8[64 * j] = (unsigned long long)pk2(v[j].x * r * g.x, v[j].y * r * g.y) | ((unsigned long long)pk2(v[j].z * r * g.z, v[j].w * r * g.w) << 32); }
        }
    }
}

template <bool GATES>
__device__ __forceinline__ void norm_phase(Frame& F, const float* hin, const float* gain, bf16* XN, const float* WG, const float* bff, const float* bmi, const float* bmf,
                                           float* FFL, float* IG, float* LF) {
    LAS float* wg = (LAS float*)(F.lds + RING_OFF);
    if (GATES) { for (int i = F.tid; i < 16 * DM / 4; i += NWAVES * 64) ((LAS f32x4*)wg)[i] = ((const GAS f32x4*)WG)[i]; __syncthreads(); }
    const int gw = F.vcu * NWAVES + F.wave, NGW = F.G * NWAVES;
    f32x4 g4[4];
#pragma unroll
    for (int j = 0; j < 4; ++j) g4[j] = ((const GAS f32x4*)gain)[F.lane + 64 * j];
    for (int m = gw; m < M; m += NGW) {
        const GAS f32x4* xr = (const GAS f32x4*)(hin + (size_t)m * DM) + F.lane;
        f32x4 v[4]; float s2 = 0.f;
#pragma unroll
        for (int j = 0; j < 4; ++j) { v[j] = xr[64 * j]; s2 += (v[j].x * v[j].x + v[j].y * v[j].y) + (v[j].z * v[j].z + v[j].w * v[j].w); }
        const float r = 1.f / sqrtf(wave_sum(s2) * (1.f / DM) + EPS);
        GAS unsigned long long* o8 = (GAS unsigned long long*)(XN + (size_t)m * DM) + F.lane;
#pragma unroll
        for (int j = 0; j < 4; ++j) { v[j] = v[j] * r * g4[j]; o8[64 * j] = (unsigned long long)pk2(v[j].x, v[j].y) | ((unsigned long long)pk2(v[j].z, v[j].w) << 32); }
        if (GATES) {
            float gv[16];
#pragma unroll
            for (int c = 0; c < 16; ++c) { float p = 0.f;
#pragma unroll
                for (int j = 0; j < 4; ++j) { const f32x4 w = *(const LAS f32x4*)(wg + c * DM + 256 * j + 4 * F.lane); p += (v[j].x * w.x + v[j].y * w.y) + (v[j].z * w.z + v[j].w * w.w); }
                gv[c] = p; asm volatile("" ::: "memory"); }
            float a8[8], a4[4], a2[2], a1;
            const bool h5 = (F.lane & 32) != 0, h4 = (F.lane & 16) != 0, h3 = (F.lane & 8) != 0, h2 = (F.lane & 4) != 0;
#pragma unroll
            for (int i = 0; i < 8; ++i) { const float send = h5 ? gv[i] : gv[i + 8], keep = h5 ? gv[i + 8] : gv[i]; a8[i] = keep + __shfl_xor(send, 32); }
#pragma unroll
            for (int i = 0; i < 4; ++i) { const float send = h4 ? a8[i] : a8[i + 4], keep = h4 ? a8[i + 4] : a8[i]; a4[i] = keep + __shfl_xor(send, 16); }
#pragma unroll
            for (int i = 0; i < 2; ++i) { const float send = h3 ? a4[i] : a4[i + 2], keep = h3 ? a4[i + 2] : a4[i]; a2[i] = keep + __shfl_xor(send, 8); }
            { const float send = h2 ? a2[0] : a2[1], keep = h2 ? a2[1] : a2[0]; a1 = keep + __shfl_xor(send, 4); }
            a1 += __shfl_xor(a1, 2); a1 += __shfl_xor(a1, 1);
            const int c = (h5 ? 8 : 0) + (h4 ? 4 : 0) + (h3 ? 2 : 0) + (h2 ? 1 : 0);
            if ((F.lane & 3) == 0) {
                if (c < 8) FFL[(size_t)m * 8 + c] = logsigmoid(a1 + bff[c]);
                else if (c < 12) IG[(size_t)m * 4 + (c - 8)] = a1 + bmi[c - 8];
                else LF[(size_t)m * 4 + (c - 12)] = logsigmoid(a1 + bmf[c - 12]);
            }
        }
    }
    if (GATES) __syncthreads();
}

__device__ __forceinline__ void fox_scan(Frame& F, const float* FFL, float* CN2) {
    LAS float* wt = (LAS float*)(F.lds + RING_OFF);
    for (int seq = blockIdx.x; seq < NB * 8; seq += gridDim.x) {
        const int b = seq >> 3, hh = seq & 7;
        const float* src = FFL + (size_t)b * SEQ * 8 + hh;
        float x[8]; float run = 0.f;
#pragma unroll
        for (int k = 0; k < 8; ++k) { run += src[(size_t)(F.tid * 8 + k) * 8]; x[k] = run; }
        float incl = run;
#pragma unroll
        for (int o = 1; o < 64; o <<= 1) { const float t = __shfl_up(incl, o); if (F.lane >= o) incl += t; }
        if (F.lane == 63) wt[F.wave] = incl;
        __syncthreads();
        float off = 0.f;
#pragma unroll
        for (int w = 0; w < NWAVES; ++w) if (w < F.wave) off += wt[w];
        const float excl = off + incl - run;
#pragma unroll
        for (int k = 0; k < 8; ++k) CN2[(size_t)seq * SEQ + F.tid * 8 + k] = -LOG2E * (excl + x[k]);
        __syncthreads();
    }
}

__device__ __forceinline__ void fox_naive(Frame& F, bf16* FQ, const bf16* FK, const bf16* FV, const float* CN2) {
    LAS float* Ks = (LAS float*)(F.lds + RING_OFF);
    LAS float* Vs = Ks + 4096;
    LAS float* Cbs = Vs + 4096;
    constexpr unsigned QMAP = 7u | (6u << 4) | (0u << 8) | (1u << 12) | (5u << 16) | (4u << 20) | (2u << 24) | (3u << 28);
    for (int u = blockIdx.x; u < 1024; u += gridDim.x) {
        const int bh = u & 127, qblk = (int)((QMAP >> (4 * (u >> 7))) & 7u), b = bh >> 3, hh = bh & 7;
        const int t = qblk * 512 + F.tid; const size_t tok = (size_t)b * SEQ + t;
        float q[64], o[64];
#pragma unroll
        for (int c = 0; c < 8; ++c) { const v4u w = *(const GAS v4u*)(FQ + tok * 512 + hh * 64 + c * 8); unpack8(w, q + 8 * c); }
#pragma unroll
        for (int d = 0; d < 64; ++d) o[d] = 0.f;
        float mx = -INFINITY, l = 0.f;
        const int tmaxw = qblk * 512 + F.wave * 64 + 63, ntiles = qblk * 8 + 8;
        for (int jt = 0; jt < ntiles; ++jt) {
            { const int key = F.tid >> 3, ch = F.tid & 7; const size_t row = (size_t)b * SEQ + jt * 64 + key;
              float f[8];
              unpack8(*(const GAS v4u*)(FK + row * 512 + hh * 64 + ch * 8), f);
              *(LAS f32x4*)(Ks + key * 64 + ch * 8) = (f32x4){f[0], f[1], f[2], f[3]}; *(LAS f32x4*)(Ks + key * 64 + ch * 8 + 4) = (f32x4){f[4], f[5], f[6], f[7]};
              unpack8(*(const GAS v4u*)(FV + row * 512 + hh * 64 + ch * 8), f);
              *(LAS f32x4*)(Vs + key * 64 + ch * 8) = (f32x4){f[0], f[1], f[2], f[3]}; *(LAS f32x4*)(Vs + key * 64 + ch * 8 + 4) = (f32x4){f[4], f[5], f[6], f[7]};
              if (F.tid < 64) Cbs[F.tid] = CN2[(size_t)bh * SEQ + jt * 64 + F.tid]; }
            __syncthreads();
            if (jt * 64 <= tmaxw) {
                for (int jj = 0; jj < 64; ++jj) {
                    float s = Cbs[jj];
#pragma unroll
                    for (int d4 = 0; d4 < 16; ++d4) { const f32x4 kv = *(const LAS f32x4*)(Ks + jj * 64 + 4 * d4); s += (q[4 * d4] * kv.x + q[4 * d4 + 1] * kv.y) + (q[4 * d4 + 2] * kv.z + q[4 * d4 + 3] * kv.w); }
                    if (jt * 64 + jj > t) s = -INFINITY;
                    const float mn = fmaxf(mx, s), alpha = exp2f(mx - mn), p = exp2f(s - mn);
                    l = l * alpha + p; mx = mn;
#pragma unroll
                    for (int d4 = 0; d4 < 16; ++d4) { const f32x4 vv = *(const LAS f32x4*)(Vs + jj * 64 + 4 * d4);
                        o[4 * d4] = o[4 * d4] * alpha + p * vv.x; o[4 * d4 + 1] = o[4 * d4 + 1] * alpha + p * vv.y; o[4 * d4 + 2] = o[4 * d4 + 2] * alpha + p * vv.z; o[4 * d4 + 3] = o[4 * d4 + 3] * alpha + p * vv.w; }
                }
            }
            __syncthreads();
        }
        const float inv = 1.f / l;
#pragma unroll
        for (int c = 0; c < 8; ++c) { v4u w; w.x = pk2(o[8 * c] * inv, o[8 * c + 1] * inv); w.y = pk2(o[8 * c + 2] * inv, o[8 * c + 3] * inv); w.z = pk2(o[8 * c + 4] * inv, o[8 * c + 5] * inv); w.w = pk2(o[8 * c + 6] * inv, o[8 * c + 7] * inv);
            *(GAS v4u*)(FQ + tok * 512 + hh * 64 + c * 8) = w; }
    }
}

__device__ __forceinline__ void xattn_naive(Frame& F, const bf16* QX, const bf16* XK, const bf16* XVT, bf16* OX) {
    const int gw = F.vcu * NWAVES + F.wave, NGW = F.G * NWAVES;
    for (int it = gw; it < M * 4; it += NGW) {
        const int tok = it >> 2, hh = it & 3, b = tok >> 12;
        float q4[4];
        { const unsigned long long w = *(const GAS unsigned long long*)(QX + (size_t)tok * DM + hh * 256 + 4 * F.lane);
          q4[0] = __uint_as_float((unsigned)w << 16); q4[1] = __uint_as_float((unsigned)w & 0xffff0000u); q4[2] = __uint_as_float((unsigned)(w >> 32) << 16); q4[3] = __uint_as_float((unsigned)(w >> 32) & 0xffff0000u); }
        float sc[4];
#pragma unroll
        for (int i = 0; i < 4; ++i) { sc[i] = 0.f;
            for (int jj = 0; jj < 64; ++jj) {
                const unsigned long long w = *(const GAS unsigned long long*)(XK + (size_t)(b * NMEM + 64 * i + jj) * DM + hh * 256 + 4 * F.lane);
                const float p = (q4[0] * __uint_as_float((unsigned)w << 16) + q4[1] * __uint_as_float((unsigned)w & 0xffff0000u)) + (q4[2] * __uint_as_float((unsigned)(w >> 32) << 16) + q4[3] * __uint_as_float((unsigned)(w >> 32) & 0xffff0000u));
                const float s = wave_sum(p);
                if (F.lane == jj) sc[i] = s;
            } }
        const float mx = wave_max(fmaxf(fmaxf(sc[0], sc[1]), fmaxf(sc[2], sc[3])));
        float p4[4];
#pragma unroll
        for (int i = 0; i < 4; ++i) p4[i] = exp2f(sc[i] - mx);
        const float lsum = wave_sum((p4[0] + p4[1]) + (p4[2] + p4[3]));
        float ov[4];
#pragma unroll
        for (int i = 0; i < 4; ++i) { ov[i] = 0.f;
            for (int dd = 0; dd < 64; ++dd) {
                const bf16* row = XVT + (size_t)(hh * 256 + 64 * i + dd) * MROWS + b * NMEM + F.lane;
                const float part = (p4[0] * bf2f(row[0]) + p4[1] * bf2f(row[64])) + (p4[2] * bf2f(row[128]) + p4[3] * bf2f(row[192]));
                const float tot = wave_sum(part);
                if (F.lane == dd) ov[i] = tot;
            } }
        const float inv = 1.f / lsum;
#pragma unroll
        for (int i = 0; i < 4; ++i) OX[(size_t)tok * DM + hh * 256 + 64 * i + F.lane] = (bf16)f2bf(ov[i] * inv);
    }
}

constexpr int ML_QS = 0, ML_KSO = 33792, ML_VS = 67584, ML_PS = 83968, ML_CB = 100608, ML_SM = 133376;
__device__ __forceinline__ void mlstm_naive(Frame& F, const bf16* MQK, const bf16* MV, bf16* MO, const float* IG, const float* LF, const float* conv_w, const float* conv_b, const float* mnorm) {
    LAS float* qs = (LAS float*)(F.lds + ML_QS);
    LAS float* ks = (LAS float*)(F.lds + ML_KSO);
    LAS bf16* vs = (LAS bf16*)(F.lds + ML_VS);
    LAS float* Ps = (LAS float*)(F.lds + ML_PS);
    LAS bf16* Cb = (LAS bf16*)(F.lds + ML_CB);
    LAS float* sm = (LAS float*)(F.lds + ML_SM);
    LAS float* s_bcum = sm, *s_ig = sm + 64, *s_mt = sm + 128, *s_iw = sm + 192, *s_wk = sm + 256, *s_den = sm + 320, *s_nv = sm + 384  , *s_nrm = sm + 512  , *s_scal = sm + 640;
    const int e = F.tid & 127, lg = F.tid >> 7;
    for (int u = blockIdx.x; u < NB * 4; u += gridDim.x) {
        const int b = u >> 2, hh = u & 3;
        float Cr[32];
#pragma unroll
        for (int i = 0; i < 32; ++i) { Cr[i] = 0.f; Cb[(lg * 32 + i) * 128 + e] = 0; }
        float nreg = 0.f; if (F.tid < 128) s_nv[F.tid] = 0.f;
        float m_prev = 0.f;
        const int ch = F.tid & 255, th = F.tid >> 8;
        const int gc = (ch < 128) ? (hh * 128 + ch) : (512 + hh * 128 + (ch - 128));
        const float cw0 = conv_w[gc], cw1 = conv_w[1024 + gc], cw2 = conv_w[2048 + gc], cw3 = conv_w[3072 + gc], cbv = conv_b[gc];
        const float mng = mnorm[hh * 128 + e];
        __syncthreads();
        for (int c = 0; c < SEQ / 64; ++c) {
            const size_t tok0 = (size_t)b * SEQ + c * 64;
            { const int tt0 = c * 64 + th * 32;
              const bf16* src = MQK + ((size_t)b * SEQ + tt0) * 1024 + gc;
              float xm3 = (tt0 >= 3) ? bf2f(src[-3 * 1024]) : 0.f, xm2 = (tt0 >= 2) ? bf2f(src[-2 * 1024]) : 0.f, xm1 = (tt0 >= 1) ? bf2f(src[-1 * 1024]) : 0.f;
              LAS float* dst = (ch < 128) ? (qs + ch) : (ks + (ch - 128));
              const float osc = (ch < 128) ? 1.f : ML_KS;
              _Pragma("unroll 1") for (int i = 0; i < 32; ++i) { const float x0 = bf2f(src[(size_t)i * 1024]);
                  const float y = cbv + cw0 * xm3 + cw1 * xm2 + cw2 * xm1 + cw3 * x0;
                  dst[(th * 32 + i) * 132] = osc * y / (1.f + __expf(-y));
                  xm3 = xm2; xm2 = xm1; xm1 = x0; } }
#pragma unroll
            for (int k = 0; k < 2; ++k) { const int idx = F.tid + 512 * k, row = idx >> 4, c8 = idx & 15;
                *(LAS v4u*)(vs + row * 128 + c8 * 8) = *(const GAS v4u*)(MV + (tok0 + row) * 512 + hh * 128 + c8 * 8); }
            __syncthreads();
            if (F.wave == 0) {
                const float ig = IG[(tok0 + F.lane) * 4 + hh], lf = LF[(tok0 + F.lane) * 4 + hh];
                float bcum = lf;
#pragma unroll
                for (int o = 1; o < 64; o <<= 1) { const float t = __shfl_up(bcum, o); if (F.lane >= o) bcum += t; }
                const float bL = __shfl(bcum, 63);
                const float a = bL - bcum + ig, m_loc = wave_max(a);
                float pm = ig - bcum;
#pragma unroll
                for (int o = 1; o < 64; o <<= 1) { const float t = __shfl_up(pm, o); if (F.lane >= o) pm = fmaxf(pm, t); }
                const float il = bcum + m_prev, mt = fmaxf(il, bcum + pm), iw = expf(il - mt);
                const float m_new = fmaxf(bL + m_prev, m_loc), s_old = expf(bL + m_prev - m_new), wk = expf(a - m_new);
                s_bcum[F.lane] = bcum; s_ig[F.lane] = ig; s_mt[F.lane] = mt; s_iw[F.lane] = iw; s_wk[F.lane] = wk; if (F.lane == 0) s_scal[0] = s_old;
                m_prev = m_new;
            }
            __syncthreads();
            { const int l = F.tid >> 3, sb = F.tid & 7; float dt[8];
#pragma unroll
              for (int i = 0; i < 8; ++i) dt[i] = 0.f;
              _Pragma("unroll 1") for (int d4 = 0; d4 < 32; ++d4) { const f32x4 qv = *(const LAS f32x4*)(qs + l * 132 + 4 * d4);
#pragma unroll
                  for (int i = 0; i < 8; ++i) { const f32x4 kv = *(const LAS f32x4*)(ks + (i * 8 + sb) * 132 + 4 * d4); dt[i] += (qv.x * kv.x + qv.y * kv.y) + (qv.z * kv.z + qv.w * kv.w); } }
              const float bl = s_bcum[l], ml = s_mt[l];
#pragma unroll
              for (int i = 0; i < 8; ++i) { const int s = i * 8 + sb; Ps[l * 65 + s] = (s <= l) ? dt[i] * expf(bl - s_bcum[s] + s_ig[s] - ml) : 0.f; } }
            __syncthreads();
            if (F.wave == 0) { const int l = F.lane; float qn = 0.f, rs = 0.f;
                _Pragma("unroll 1") for (int d4 = 0; d4 < 32; ++d4) { const f32x4 qv = *(const LAS f32x4*)(qs + l * 132 + 4 * d4); const f32x4 nv = *(const LAS f32x4*)(s_nv + 4 * d4); qn += (qv.x * nv.x + qv.y * nv.y) + (qv.z * nv.z + qv.w * nv.w); }
                _Pragma("unroll 1") for (int s = 0; s < 64; ++s) rs += Ps[l * 65 + s];
                const float den = s_iw[l] * qn + rs; s_den[l] = fmaxf(fabsf(den), expf(-s_mt[l])); }
            float ai[16], ax[16];
#pragma unroll
            for (int i = 0; i < 16; ++i) { ai[i] = 0.f; ax[i] = 0.f; }
            _Pragma("unroll 1") for (int d4 = 0; d4 < 32; ++d4) {
                const float c0 = bf2f(Cb[(4 * d4) * 128 + e]), c1 = bf2f(Cb[(4 * d4 + 1) * 128 + e]), c2 = bf2f(Cb[(4 * d4 + 2) * 128 + e]), c3 = bf2f(Cb[(4 * d4 + 3) * 128 + e]);
#pragma unroll
                for (int li = 0; li < 16; ++li) { const f32x4 qv = *(const LAS f32x4*)(qs + (lg * 16 + li) * 132 + 4 * d4); ai[li] += (qv.x * c0 + qv.y * c1) + (qv.z * c2 + qv.w * c3); } }
            _Pragma("unroll 1") for (int s = 0; s < 64; ++s) { const float vv = bf2f(vs[s * 128 + e]);
#pragma unroll
                for (int li = 0; li < 16; ++li) ax[li] += Ps[(lg * 16 + li) * 65 + s] * vv; }
            __syncthreads();
            float hv[16];
#pragma unroll
            for (int li = 0; li < 16; ++li) { const int l = lg * 16 + li; hv[li] = (s_iw[l] * ai[li] + ax[li]) / s_den[l]; const float ss = wave_sum(hv[li] * hv[li]); if (F.lane == 0) s_nrm[F.wave * 16 + li] = ss; }
            { const float s_old = s_scal[0];
#pragma unroll
              for (int i = 0; i < 32; ++i) Cr[i] *= s_old;
              float nacc = 0.f;
              _Pragma("unroll 1") for (int s = 0; s < 64; ++s) { const float wks = s_wk[s]; const float vv = wks * bf2f(vs[s * 128 + e]);
#pragma unroll
                  for (int i4 = 0; i4 < 8; ++i4) { const f32x4 kv = *(const LAS f32x4*)(ks + s * 132 + lg * 32 + 4 * i4); Cr[4 * i4] += kv.x * vv; Cr[4 * i4 + 1] += kv.y * vv; Cr[4 * i4 + 2] += kv.z * vv; Cr[4 * i4 + 3] += kv.w * vv; }
                  if (F.tid < 128) nacc += wks * ks[s * 132 + F.tid]; }
              if (F.tid < 128) { nreg = s_old * nreg + nacc; s_nv[F.tid] = nreg; }
#pragma unroll
              for (int i = 0; i < 32; ++i) Cb[(lg * 32 + i) * 128 + e] = (bf16)f2bf(Cr[i]); }
            __syncthreads();
#pragma unroll
            for (int li = 0; li < 16; ++li) { const int l = lg * 16 + li; const float ss = s_nrm[(2 * lg) * 16 + li] + s_nrm[(2 * lg + 1) * 16 + li];
                const float rs = 1.f / sqrtf(ss * (1.f / 128.f) + EPS);
                bf16* p = MO + (tok0 + l) * 512 + hh * 128 + e; const float mo = bf2f(*p);
                *p = (bf16)f2bf(hv[li] * rs * mng / (1.f + __expf(-mo))); }
            __syncthreads();
        }
    }
}

__device__ __forceinline__ void final_norm(Frame& F, float* out, const float* gain) {
    const int gw = F.vcu * NWAVES + F.wave, NGW = F.G * NWAVES;
    f32x4 g4[4];
#pragma unroll
    for (int j = 0; j < 4; ++j) g4[j] = ((const GAS f32x4*)gain)[F.lane + 64 * j];
    for (int m = gw; m < M; m += NGW) {
        GAS f32x4* xr = (GAS f32x4*)(out + (size_t)m * DM) + F.lane;
        f32x4 v[4]; float s2 = 0.f;
#pragma unroll
        for (int j = 0; j < 4; ++j) { v[j] = xr[64 * j]; s2 += (v[j].x * v[j].x + v[j].y * v[j].y) + (v[j].z * v[j].z + v[j].w * v[j].w); }
        const float r = 1.f / sqrtf(wave_sum(s2) * (1.f / DM) + EPS);
#pragma unroll
        for (int j = 0; j < 4; ++j) xr[64 * j] = v[j] * r * g4[j];
    }
}
#ifndef MK_PER_PHASE
#define MK_PER_PHASE 0
#endif
#ifndef LAYERS_TEST
#define LAYERS_TEST DEPTH
#endif
#ifndef SITE_MASK
#define SITE_MASK 0xffffffffu
#endif
#define SITE_ON(k) ((SITE_MASK >> (k)) & 1u)
constexpr int PH_PER_LAYER = 16, NPH = 2 + DEPTH * PH_PER_LAYER + 1;
struct Args { const float* in[23]; float* out; unsigned char* ws; int ph_lo, ph_hi; };
__global__ void __launch_bounds__(NWAVES * 64, 2) trunk_fwd(Args args) {
    extern __shared__ __attribute__((aligned(16))) unsigned char lds[];
    Frame F;
    F.lds = (LAS unsigned char*)lds;
    F.MISC = (volatile LAS unsigned*)(F.lds + MISC_OFF);
    F.tid = threadIdx.x; F.lane = F.tid & 63; F.wave = __builtin_amdgcn_readfirstlane(F.tid >> 6);
    F.G = gridDim.x; { const int bx = blockIdx.x; F.vcu = (F.G % 8 == 0) ? (bx % 8) * (F.G / 8) + bx / 8 : bx; }
    F.ctl = (gu32*)(args.ws + WS_CTL);
    for (int u = F.tid; u < (LDS_BYTES - LDSCTL_OFF) / 4; u += NWAVES * 64) ((LAS unsigned*)(F.lds + LDSCTL_OFF))[u] = 0u;
    __syncthreads();
    XcdBarrier bar; bar.bar = (unsigned*)(F.ctl + CW_BAR); bar.x = 0; bar.st = nullptr;
    if (!MK_PER_PHASE) bar = xcd_barrier_post((unsigned*)(F.ctl + CW_BAR), F.MISC + 8);
    const int lo = args.ph_lo, hi = args.ph_hi;
#define IN(k) (lo <= (k) && (k) < hi)
#define SEAM(k) do { if (!MK_PER_PHASE && IN((k) + 1)) xcd_barrier(bar); } while (0)
    constexpr size_t SL = SLOT / 2;

#define SITE_CTX(lay) const KAS char* ka = (const KAS char*)__builtin_amdgcn_kernarg_segment_ptr(); asm volatile("" : "+s"(ka)); \
    int ll = (lay); asm volatile("" : "+s"(ll)); Frame Fl = F; { int t_ = threadIdx.x; asm volatile("" : "+v"(t_)); Fl.tid = t_; Fl.lane = t_ & 63; } int gG = F.G, gB = (int)blockIdx.x; asm volatile("" : "+s"(gG), "+s"(gB)); \
    unsigned char* ws = *(unsigned char* const KAS*)(ka + 192); float* out = *(float* const KAS*)(ka + 184); const float* x = INP(0); \
    unsigned char* wl = ws + WS_W + (size_t)ll * WL; const float* hin0 = (ll == 0) ? x : out; bf16* XN = (bf16*)(ws + WS_XN); bf16* BIG = (bf16*)(ws + WS_BIG); \
    float* FFL = (float*)(ws + WS_FFL); float* IG = (float*)(ws + WS_IG); float* LF = (float*)(ws + WS_LF); float* CN2 = (float*)(ws + WS_CN2); \
    (void)wl; (void)hin0; (void)gG; (void)gB; (void)XN; (void)BIG; (void)FFL; (void)IG; (void)LF; (void)CN2; (void)x; (void)out
#define INP(k) (*(const float* const KAS*)(ka + 8 * (k)))
    static_assert(sizeof(Args) == 208, "kernarg layout: in[23] at 0, out at 184, ws at 192, ph_lo at 200, ph_hi at 204");

    if (IN(0)) { SITE_CTX(0); p0_prologue(Fl, ka, ws); SEAM(0); }
    if (IN(1)) { SITE_CTX(0);
        for (int l = 0; l < DEPTH; ++l) {
            const bf16* memn = (const bf16*)(ws + WS_BIG + 16 * MiB + (size_t)l * 8 * MiB);
            const bf16* wxk = (const bf16*)(ws + WS_BIG + (size_t)l * 4 * MiB); const bf16* wxv = (const bf16*)(ws + WS_BIG + (size_t)l * 4 * MiB + 2 * MiB);
            { pg8::Gemm g{memn, wxk, MROWS, DM, DM}; pg8::StaticOrder S; S.init(MROWS, DM, F.G, (int)blockIdx.x);
              pg8::EpiB<0> E{(bf16*)(ws + WS_XK + (size_t)l * 8 * MiB), DM, nullptr, nullptr, nullptr};

#if SITE_ON(0)
pg8::gemm_phase<pg8::EpiB<0>, pg8::StaticOrder, true, true>(F.lds + RING_OFF, g, S, E);
#endif
 }
            { pg8::Gemm g{wxv, memn, DM, MROWS, DM}; pg8::StaticOrder S; S.init(DM, MROWS, F.G, (int)blockIdx.x);
              pg8::EpiB<0> E{(bf16*)(ws + WS_XVT + (size_t)l * 8 * MiB), MROWS, nullptr, nullptr, nullptr};

#if SITE_ON(1)
pg8::gemm_phase<pg8::EpiB<0>, pg8::StaticOrder, true, true>(F.lds + RING_OFF, g, S, E);
#endif
 }
        }
        SEAM(1);
    }
    for (int l = 0; l < LAYERS_TEST; ++l) {
        const int pb = 2 + PH_PER_LAYER * l;
        if (IN(pb + 0)) { SITE_CTX(l); norm_phase<true>(Fl, hin0, INP(2) + (size_t)ll * DM, XN, (const float*)(wl + WT_WG), INP(7) + ll * 8, INP(8) + ll * 4, INP(9) + ll * 4, FFL, IG, LF); SEAM(pb + 0); }
        if (IN(pb + 1)) { SITE_CTX(l);
            fox_scan(Fl, FFL, CN2);
            pg8::Gemm g{XN, (const bf16*)(wl + WT_IN), M, 3584, DM}; pg8::StaticOrder S; S.init(M, 3584, gG, gB);
            pg8::EpiB<5> E{BIG, 0, nullptr, nullptr, nullptr};

#if SITE_ON(2)
pg8::gemm_phase<pg8::EpiB<5>, pg8::StaticOrder, true, true>(F.lds + RING_OFF, g, S, E);
#endif

            SEAM(pb + 1);
        }
        if (IN(pb + 2)) { SITE_CTX(l);
#ifndef NO_FOX
 fox_naive(Fl, BIG, BIG + SL, BIG + 2 * SL, CN2);
#endif
 SEAM(pb + 2); }
        if (IN(pb + 3)) { SITE_CTX(l);
#ifndef NO_ML
 mlstm_naive(Fl, BIG + 3 * SL, BIG + 5 * SL, BIG + 6 * SL, IG, LF, INP(11) + (size_t)ll * 4 * 1024, INP(12) + (size_t)ll * 1024, INP(13) + (size_t)ll * 512);
#endif
 SEAM(pb + 3); }
        if (IN(pb + 4)) { SITE_CTX(l);
            pg8::Gemm g{XN, (const bf16*)(wl + WT_GF), M, DM, DM}; pg8::StaticOrder S; S.init(M, DM, gG, gB);
            pg8::EpiB<1> E{BIG + SL, DM, INP(10) + (size_t)ll * 2048, nullptr, nullptr};

#if SITE_ON(3)
pg8::gemm_phase<pg8::EpiB<1>, pg8::StaticOrder, true, true>(F.lds + RING_OFF, g, S, E);
#endif

            SEAM(pb + 4);
        }
        if (IN(pb + 5)) { SITE_CTX(l);
            pg8::Gemm g{BIG, (const bf16*)(wl + WT_UPF), M, DM, 512}; pg8::StaticOrder S; S.init(M, DM, gG, gB);
            pg8::EpiB<2> E{BIG + SL, DM, nullptr, BIG + SL, nullptr};

#if SITE_ON(4)
pg8::gemm_phase<pg8::EpiB<2>, pg8::StaticOrder, true, true>(F.lds + RING_OFF, g, S, E);
#endif

            SEAM(pb + 5);
        }
        if (IN(pb + 6)) { SITE_CTX(l);
            pg8::Gemm g{XN, (const bf16*)(wl + WT_GM), M, DM, DM}; pg8::StaticOrder S; S.init(M, DM, gG, gB);
            pg8::EpiB<1> E{BIG + 3 * SL, DM, INP(10) + (size_t)ll * 2048 + 1024, nullptr, nullptr};

#if SITE_ON(5)
pg8::gemm_phase<pg8::EpiB<1>, pg8::StaticOrder, true, true>(F.lds + RING_OFF, g, S, E);
#endif

            SEAM(pb + 6);
        }
        if (IN(pb + 7)) { SITE_CTX(l);
            pg8::Gemm g{BIG + 6 * SL, (const bf16*)(wl + WT_UPM), M, DM, 512}; pg8::StaticOrder S; S.init(M, DM, gG, gB);
            pg8::EpiB<3> E{BIG + SL, DM, nullptr, BIG + 3 * SL, BIG + SL};

#if SITE_ON(6)
pg8::gemm_phase<pg8::EpiB<3>, pg8::StaticOrder, true, true>(F.lds + RING_OFF, g, S, E);
#endif

            SEAM(pb + 7);
        }
        if (IN(pb + 8)) { SITE_CTX(l);
            pg8::Gemm g{BIG + SL, (const bf16*)(wl + WT_MIX), M, DM, DM}; pg8::StaticOrder S; S.init(M, DM, gG, gB);
            pg8::EpiResid E{hin0, out, DM};

#if SITE_ON(7)
pg8::gemm_phase<pg8::EpiResid, pg8::StaticOrder, true, true>(F.lds + RING_OFF, g, S, E);
#endif

            SEAM(pb + 8);
        }
        if (IN(pb + 9)) { SITE_CTX(l); norm_phase<false>(Fl, out, INP(3) + (size_t)ll * DM, XN, nullptr, nullptr, nullptr, nullptr, nullptr, nullptr, nullptr); SEAM(pb + 9); }
        if (IN(pb + 10)) { SITE_CTX(l);
            pg8::Gemm g{XN, (const bf16*)(wl + WT_XQ), M, DM, DM}; pg8::StaticOrder S; S.init(M, DM, gG, gB);
            pg8::EpiB<0> E{BIG, DM, nullptr, nullptr, nullptr};

#if SITE_ON(8)
pg8::gemm_phase<pg8::EpiB<0>, pg8::StaticOrder, true, true>(F.lds + RING_OFF, g, S, E);
#endif

            SEAM(pb + 10);
        }
        if (IN(pb + 11)) { SITE_CTX(l);
#ifndef NO_XA
 xattn_naive(Fl, BIG, (const bf16*)(ws + WS_XK + (size_t)ll * 8 * MiB), (const bf16*)(ws + WS_XVT + (size_t)ll * 8 * MiB), BIG + 2 * SL);
#endif
 SEAM(pb + 11); }
        if (IN(pb + 12)) { SITE_CTX(l);
            pg8::Gemm g{BIG + 2 * SL, (const bf16*)(wl + WT_XO), M, DM, DM}; pg8::StaticOrder S; S.init(M, DM, gG, gB);
            pg8::EpiResid E{out, out, DM};

#if SITE_ON(9)
pg8::gemm_phase<pg8::EpiResid, pg8::StaticOrder, true, true>(F.lds + RING_OFF, g, S, E);
#endif

            SEAM(pb + 12);
        }
        if (IN(pb + 13)) { SITE_CTX(l); norm_phase<false>(Fl, out, INP(5) + (size_t)ll * DM, XN, nullptr, nullptr, nullptr, nullptr, nullptr, nullptr, nullptr); SEAM(pb + 13); }
        if (IN(pb + 14)) { SITE_CTX(l);
            pg8::Gemm g{XN, (const bf16*)(wl + WT_M1), M, DFF, DM}; pg8::StaticOrder S; S.init(M, DFF, gG, gB);
            pg8::EpiB<4> E{BIG, DFF, nullptr, nullptr, nullptr};

#if SITE_ON(10)
pg8::gemm_phase<pg8::EpiB<4>, pg8::StaticOrder, true, true>(F.lds + RING_OFF, g, S, E);
#endif

            SEAM(pb + 14);
        }
        if (IN(pb + 15)) { SITE_CTX(l);
            pg8::Gemm g{BIG, (const bf16*)(wl + WT_M2), M, DM, DFF}; pg8::StaticOrder S; S.init(M, DM, gG, gB);
            pg8::EpiResid E{out, out, DM};

#if SITE_ON(11)
pg8::gemm_phase<pg8::EpiResid, pg8::StaticOrder, true, true>(F.lds + RING_OFF, g, S, E);
#endif

            SEAM(pb + 15);
        }
    }
    if (IN(NPH - 1)) { SITE_CTX(0); final_norm(Fl, out, INP(22)); }
#undef IN
#undef SEAM
}

extern "C" void kernel_launch(void* const* d_in, const int* in_sizes, int n_in, void* d_out, int out_size, void* d_ws, size_t ws_size, hipStream_t stream) {
    static int grid = 0;
    if (grid == 0) {
        if (n_in != 23 || in_sizes[0] != M * DM || out_size != M * DM || ws_size < WS_END) { fprintf(stderr, "kernel_launch: unexpected problem (n_in %d, in0 %d, out %d, ws %zu); nothing launched\n", n_in, n_in > 0 ? in_sizes[0] : -1, out_size, ws_size); grid = -1; return; }
        int dev = 0, cus = 0, per_cu = 0;
        if (hipGetDevice(&dev) != hipSuccess || hipDeviceGetAttribute(&cus, hipDeviceAttributeMultiprocessorCount, dev) != hipSuccess) { grid = -1; return; }
        if (hipFuncSetAttribute((const void*)trunk_fwd, hipFuncAttributeMaxDynamicSharedMemorySize, LDS_BYTES) != hipSuccess) { fprintf(stderr, "kernel_launch: hipFuncSetAttribute failed\n"); grid = -1; return; }
        if (hipOccupancyMaxActiveBlocksPerMultiprocessor(&per_cu, (const void*)trunk_fwd, NWAVES * 64, LDS_BYTES) != hipSuccess || per_cu < 1)
            fprintf(stderr, "kernel_launch: note: occupancy query reports %d workgroups per CU\n", per_cu);
        (void)hipGetLastError();
        grid = cus;
    }
    if (grid < 0) return;
    if (hipMemsetAsync((char*)d_ws + WS_CTL, 0, CTL_ZERO_BYTES, stream) != hipSuccess) return;
    Args a{};
    for (int i = 0; i < 23; ++i) a.in[i] = (const float*)d_in[i];
    a.out = (float*)d_out; a.ws = (unsigned char*)d_ws;
#if MK_PER_PHASE
    for (int p = 0; p < NPH; ++p) { a.ph_lo = p; a.ph_hi = p + 1; hipLaunchKernelGGL(trunk_fwd, dim3(grid), dim3(NWAVES * 64), LDS_BYTES, stream, a); }
#else
    a.ph_lo = 0; a.ph_hi = NPH; hipLaunchKernelGGL(trunk_fwd, dim3(grid), dim3(NWAVES * 64), LDS_BYTES, stream, a);
#endif
}
```

```cpp
#include <hip/hip_runtime.h>
#include <cstdio>
#include <cstdint>
#include <cmath>
namespace pg8 {
#define PG8_LAS __attribute__((address_space(3)))
typedef unsigned short bf16_t;
typedef short bf16x8 __attribute__((ext_vector_type(8)));
typedef float f32x4 __attribute__((ext_vector_type(4)));
typedef unsigned u32x4 __attribute__((ext_vector_type(4)));
constexpr int BM = 256, BK = 64, HALF = 128, HTB = HALF * BK * 2  , STAGE_BYTES = 8 * HTB, NXCD = 8, WGM = 8;

__host__ __device__ __forceinline__ int lds_byte(int r, int c) { const int st = (r >> 4) * 2 + (c >> 5), rr = r & 15, cc = c & 31, ob = rr * 64 + cc * 2; return st * 1024 + (ob ^ (((ob >> 9) & 1) << 5)); }
__host__ __device__ __forceinline__ void stage_rc(int b, int& R, int& C) { const int st = b / 1024, sb = b % 1024, swz = sb ^ (((sb >> 9) & 1) << 5); R = (st >> 1) * 16 + swz / 64; C = (st & 1) * 32 + (swz % 64) / 2; }
__host__ __device__ __forceinline__ int perm32(int rho) { const int n = rho >> 4, i = rho & 15; return 8 * (i >> 2) + 4 * n + (i & 3); }

struct Unit { int pm, pn; };
struct Gemm { const bf16_t* A; const bf16_t* Bt; int M, N, K; int lda, ldb;
    __host__ __device__ Gemm(const bf16_t* A_, const bf16_t* Bt_, int M_, int N_, int K_) : A(A_), Bt(Bt_), M(M_), N(N_), K(K_), lda(K_), ldb(K_) {}
    __host__ __device__ Gemm(const bf16_t* A_, const bf16_t* Bt_, int M_, int N_, int K_, int lda_, int ldb_) : A(A_), Bt(Bt_), M(M_), N(N_), K(K_), lda(lda_), ldb(ldb_) {} };
#define PG8_DEFAULT_BASES __device__ __forceinline__ const char* abase(const Gemm& g, const Unit& u) const { return (const char*)g.A + (size_t)u.pm * BM * g.lda * 2; } \
    __device__ __forceinline__ const char* bbase(const Gemm& g, const Unit& u) const { return (const char*)g.Bt + (size_t)u.pn * BM * g.ldb * 2; }

struct StaticOrder {
    int nM, nN, nwg, G, c;
    __host__ __device__ void init(int M, int N, int G_, int c_) { nM = M / BM; nN = N / BM; nwg = nM * nN; G = G_; c = c_; }
    __host__ __device__ bool next(int i, Unit& u) const {
        const long L = (long)i * G + c; if (L >= nwg) return false;
        int wgid = (int)L; { const int q = nwg / NXCD, r = nwg % NXCD, xcd = wgid % NXCD, off = wgid / NXCD; wgid = (xcd < r ? xcd * (q + 1) : r * (q + 1) + (xcd - r) * q) + off; }
        const int nig = WGM * nN, gid = wgid / nig, fm = gid * WGM, gsz = (nM - fm) < WGM ? (nM - fm) : WGM;
        u.pm = fm + ((wgid % nig) % gsz); u.pn = (wgid % nig) / gsz; return true;
    }
    __device__ __forceinline__ void a_ready(const Unit&) const {}
    __device__ __forceinline__ void done(const Unit&) const {}
    PG8_DEFAULT_BASES
};

__device__ __forceinline__ unsigned cvt_pk_bf16(float lo, float hi) { unsigned r; asm volatile("v_cvt_pk_bf16_f32 %0, %1, %2" : "=v"(r) : "v"(lo), "v"(hi)); return r; }
typedef float f32x2 __attribute__((ext_vector_type(2)));
__device__ __forceinline__ float bf2f(unsigned short b) { return __uint_as_float((unsigned)b << 16); }
__device__ __forceinline__ float fsigm(float x) { const float d = 1.0f + __builtin_amdgcn_exp2f(x * -1.4426950408889634f); float r; asm("v_rcp_f32_e32 %0, %1" : "=v"(r) : "v"(d)); return r; }
__device__ __forceinline__ f32x4 sigm4(f32x4 v) { return (f32x4){fsigm(v[0]), fsigm(v[1]), fsigm(v[2]), fsigm(v[3])}; }
__device__ __forceinline__ void unpack8(const u32x4 w, f32x4& a, f32x4& b) {
    a = (f32x4){__uint_as_float(w.x << 16), __uint_as_float(w.x & 0xffff0000u), __uint_as_float(w.y << 16), __uint_as_float(w.y & 0xffff0000u)};
    b = (f32x4){__uint_as_float(w.z << 16), __uint_as_float(w.z & 0xffff0000u), __uint_as_float(w.w << 16), __uint_as_float(w.w & 0xffff0000u)};
}
__device__ __forceinline__ float fq_sum(float v) {
    { auto r = __builtin_amdgcn_permlane16_swap(__float_as_uint(v), __float_as_uint(v), false, false); v = __uint_as_float(r[0]) + __uint_as_float(r[1]); }
    { auto r = __builtin_amdgcn_permlane32_swap(__float_as_uint(v), __float_as_uint(v), false, false); v = __uint_as_float(r[0]) + __uint_as_float(r[1]); }
    return v;
}

__device__ __forceinline__ void rs_stage(const float* ssp, PG8_LAS float* rsl, const Unit& u, int wid, int lane) {
    int l4 = lane * 4; asm volatile("" : "+v"(l4));
#pragma unroll
    for (int j = 0; j < 2; ++j) { const int r0 = 32 * wid + 16 * j;
        __builtin_amdgcn_global_load_lds((const unsigned*)(ssp + (size_t)(u.pm * BM + r0) * 16 + l4), (PG8_LAS unsigned*)(rsl + r0 * 16), 16, 0, 0); }
}
__device__ __forceinline__ void rs_scale(float (&rsc)[2][4], const PG8_LAS float* rsl, int wr, int fr, int fq) {
    int lo_ = (wr * 64 + fr) * 16 + 4 * fq; asm volatile("" : "+v"(lo_));
    const PG8_LAS float* bp = rsl + lo_;
#pragma unroll
    for (int ai = 0; ai < 2; ++ai)
#pragma unroll
        for (int m = 0; m < 4; ++m) { const f32x4 p = *(const PG8_LAS f32x4*)(bp + (ai * HALF + m * 16) * 16); rsc[ai][m] = (p[0] + p[1]) + (p[2] + p[3]); }
#pragma unroll
    for (int ai = 0; ai < 2; ++ai)
#pragma unroll
        for (int m = 0; m < 4; ++m) rsc[ai][m] = __builtin_amdgcn_rsqf(fq_sum(rsc[ai][m]) * (1.0f / 1024.0f) + 1e-6f);
}
template <int MODE, bool RS = false> struct EpiB {
    static constexpr bool PERM = true, AFTER_DRAIN = false, STAGE = RS; static constexpr bool CHAIN = false;
    bf16_t* O; int ldc; const float* bias; const bf16_t* G; const bf16_t* T; const float* ssp; PG8_LAS float* rsl;
    __device__ __forceinline__ void stage(const Unit& u, int wid, int lane) const { rs_stage(ssp, rsl, u, wid, lane); }
    __device__ __forceinline__ void operator()(const f32x4 (&acc)[2][2][4][2], const Unit& u, int wr, int wc, int fr, int fq) const {
        bf16_t* base = O; int ld = ldc; int colt = u.pn * BM;
        if (MODE == 5) {
            const int pn = u.pn; int slot;
            if (pn < 6) { slot = pn >> 1; ld = 512; colt = (pn & 1) * 256; }
            else if (pn < 10) { slot = 3; ld = 1024; colt = (pn - 6) * 256; }
            else { slot = 5 + ((pn - 10) >> 1); ld = 512; colt = ((pn - 10) & 1) * 256; }
            base = O + (size_t)slot * 33554432u;
        }
        if (MODE == 6) { base = O + (size_t)(u.pn >> 2) * 67108864u; colt = (u.pn & 3) * BM; }
        const int row0 = u.pm * BM + wr * 64 + fr;
        const int col0 = colt + wc * 32 + 8 * fq, bcol0 = u.pn * BM + wc * 32 + 8 * fq;
        f32x4 bv[2][2];
#pragma unroll
        for (int bj = 0; bj < 2; ++bj)
#pragma unroll
            for (int n = 0; n < 2; ++n) bv[bj][n] = (MODE == 1 || MODE == 6) ? *(const f32x4*)(bias + bcol0 + bj * HALF + 4 * n) : (f32x4){0.f, 0.f, 0.f, 0.f};
        float rsc[2][4];
        if (RS) rs_scale(rsc, rsl, wr, fr, fq);
        constexpr int GW = (MODE == 2) ? 8 : 4;
        u32x4 ga[GW][2], tc[2], tn[2];
        if (MODE == 2 || MODE == 3) {
#pragma unroll
            for (int it = 0; it < GW; ++it)
#pragma unroll
                for (int bj = 0; bj < 2; ++bj) ga[it][bj] = *(const u32x4*)(G + (size_t)(row0 + (it >> 2) * HALF + (it & 3) * 16) * ld + col0 + bj * HALF);
            if (MODE == 3) {
#pragma unroll
                for (int bj = 0; bj < 2; ++bj) tc[bj] = *(const u32x4*)(T + (size_t)row0 * ld + col0 + bj * HALF); } }
#pragma unroll
        for (int it = 0; it < 8; ++it) { const int ai = it >> 2, m = it & 3; const size_t roff = (size_t)(row0 + ai * HALF + m * 16) * ld + col0;
            if (MODE == 3 && it < 7) { const int ai2 = (it + 1) >> 2, m2 = (it + 1) & 3; const size_t roff2 = (size_t)(row0 + ai2 * HALF + m2 * 16) * ld + col0;
#pragma unroll
                for (int bj = 0; bj < 2; ++bj) tn[bj] = *(const u32x4*)(T + roff2 + bj * HALF); }
            if (MODE == 3) asm volatile("" ::: "memory");
#pragma unroll
            for (int bj = 0; bj < 2; ++bj) { f32x4 v0 = acc[ai][bj][m][0], v1 = acc[ai][bj][m][1];
                if (RS) { v0 = v0 * rsc[ai][m]; v1 = v1 * rsc[ai][m]; }
                if (MODE == 1 || MODE == 6) { v0 = sigm4(v0 + bv[bj][0]); v1 = sigm4(v1 + bv[bj][1]); }
                if (MODE == 2 || MODE == 3) { f32x4 g0, g1; unpack8(ga[it % GW][bj], g0, g1); v0 = v0 * g0; v1 = v1 * g1;
                    if (it + GW < 8) ga[it % GW][bj] = *(const u32x4*)(G + (size_t)(row0 + ((it + GW) >> 2) * HALF + ((it + GW) & 3) * 16) * ld + col0 + bj * HALF); }
                if (MODE == 3) { f32x4 t0, t1; unpack8(tc[bj], t0, t1); v0 = v0 + t0; v1 = v1 + t1; }
                if (MODE == 4) { v0 = __builtin_elementwise_max(v0, (f32x4){0.f, 0.f, 0.f, 0.f}); v1 = __builtin_elementwise_max(v1, (f32x4){0.f, 0.f, 0.f, 0.f}); v0 = v0 * v0; v1 = v1 * v1; }
                u32x4 w; w.x = cvt_pk_bf16(v0[0], v0[1]); w.y = cvt_pk_bf16(v0[2], v0[3]); w.z = cvt_pk_bf16(v1[0], v1[1]); w.w = cvt_pk_bf16(v1[2], v1[3]);
                if (MODE == 7) {
                    const int tb = u.pm * 8 + 2 * wr + 4 * ai + (m >> 1), ks = 2 * wc + (fq >> 1) + 8 * bj;
                    *(u32x4*)(O + ((size_t)((tb * 4 + u.pn) * 16 + ks) * 64 + (fq & 1) * 32 + 16 * (m & 1) + fr) * 8) = w; }
                else *(u32x4*)(base + roff + bj * HALF) = w;
                }
            if (MODE == 3) { asm volatile("" ::: "memory");
#pragma unroll
                for (int bj = 0; bj < 2; ++bj) tc[bj] = tn[bj]; }
        }
    }
};
template <bool STATS> struct EpiResid {
    static constexpr bool PERM = false, AFTER_DRAIN = false, STAGE = false; static constexpr bool CHAIN = false;
    const float* hin; float* out; int ldc; bf16_t* hb; float* ssp;
    __device__ __forceinline__ void operator()(const f32x4 (&acc)[2][2][4][2], const Unit& u, int wr, int wc, int fr, int fq) const {
        const int row0 = u.pm * BM + wr * 64 + fr, col0 = u.pn * BM + wc * 32 + 4 * fq;
        f32x4 rc[2][2], rn[2][2];
#pragma unroll
        for (int bj = 0; bj < 2; ++bj)
#pragma unroll
            for (int n = 0; n < 2; ++n) rc[bj][n] = *(const f32x4*)(hin + (size_t)row0 * ldc + col0 + bj * HALF + n * 16);
#pragma unroll
        for (int it = 0; it < 8; ++it) { const int ai = it >> 2, m = it & 3; const size_t off = (size_t)(row0 + ai * HALF + m * 16) * ldc + col0;
            if (it < 7) { const int ai2 = (it + 1) >> 2, m2 = (it + 1) & 3; const size_t off2 = (size_t)(row0 + ai2 * HALF + m2 * 16) * ldc + col0;
#pragma unroll
                for (int bj = 0; bj < 2; ++bj)
#pragma unroll
                    for (int n = 0; n < 2; ++n) rn[bj][n] = *(const f32x4*)(hin + off2 + bj * HALF + n * 16); }
            asm volatile("" ::: "memory");
#pragma unroll
            for (int bj = 0; bj < 2; ++bj)
#pragma unroll
                for (int n = 0; n < 2; ++n) { rc[bj][n] = rc[bj][n] + acc[ai][bj][m][n]; *(f32x4*)(out + off + bj * HALF + n * 16) = rc[bj][n]; }
            if (STATS && hb) { float ss = 0.f;
#pragma unroll
                for (int bj = 0; bj < 2; ++bj)
#pragma unroll
                    for (int n = 0; n < 2; ++n) { const f32x4 v = rc[bj][n]; ss += (v[0] * v[0] + v[1] * v[1]) + (v[2] * v[2] + v[3] * v[3]);
                        typedef unsigned u32x2 __attribute__((ext_vector_type(2))); *(u32x2*)(hb + off + bj * HALF + n * 16) = (u32x2){cvt_pk_bf16(v[0], v[1]), cvt_pk_bf16(v[2], v[3])}; }
                ss = fq_sum(ss);
                if (fq == 0) ssp[(size_t)(row0 + ai * HALF + m * 16) * 16 + 4 * u.pn + wc] = ss; }
            asm volatile("" ::: "memory");
#pragma unroll
            for (int bj = 0; bj < 2; ++bj)
#pragma unroll
                for (int n = 0; n < 2; ++n) rc[bj][n] = rn[bj][n];
        }
    }
};

#ifndef RESID_L2WARM
#define RESID_L2WARM 1
#endif
struct EpiResidB {
    static constexpr bool PERM = true, AFTER_DRAIN = false, STAGE = (RESID_L2WARM != 0); static constexpr bool CHAIN = false;
    bf16_t* H; int ldc; float* ssp; PG8_LAS unsigned char* dummy;
    __device__ __forceinline__ void stage(const Unit& u, int wid, int lane) const {
#pragma unroll
        for (int k = 0; k < 4; ++k) { const int l = k * 512 + wid * 64 + lane, row = l >> 3, seg = l & 7;
            __builtin_amdgcn_global_load_lds((const unsigned*)(H + (size_t)(u.pm * BM + row) * ldc + u.pn * BM + seg * 32), (PG8_LAS unsigned*)(dummy + wid * 512), 4, 0, 0); }
    }
    __device__ __forceinline__ void operator()(const f32x4 (&acc)[2][2][4][2], const Unit& u, int wr, int wc, int fr, int fq) const {
        const int row0 = u.pm * BM + wr * 64 + fr, col0 = u.pn * BM + wc * 32 + 8 * fq;
        u32x4 hc[2], hn[2];
#pragma unroll
        for (int bj = 0; bj < 2; ++bj) hc[bj] = *(const u32x4*)(H + (size_t)row0 * ldc + col0 + bj * HALF);
#pragma unroll
        for (int it = 0; it < 8; ++it) { const int ai = it >> 2, m = it & 3; const size_t off = (size_t)(row0 + ai * HALF + m * 16) * ldc + col0;
            if (it < 7) { const int ai2 = (it + 1) >> 2, m2 = (it + 1) & 3; const size_t off2 = (size_t)(row0 + ai2 * HALF + m2 * 16) * ldc + col0;
#pragma unroll
                for (int bj = 0; bj < 2; ++bj) hn[bj] = *(const u32x4*)(H + off2 + bj * HALF); }
            asm volatile("" ::: "memory");
            float ss = 0.f;
#pragma unroll
            for (int bj = 0; bj < 2; ++bj) { f32x4 h0, h1; unpack8(hc[bj], h0, h1); const f32x4 v0 = h0 + acc[ai][bj][m][0], v1 = h1 + acc[ai][bj][m][1];
                ss += ((v0[0] * v0[0] + v0[1] * v0[1]) + (v0[2] * v0[2] + v0[3] * v0[3])) + ((v1[0] * v1[0] + v1[1] * v1[1]) + (v1[2] * v1[2] + v1[3] * v1[3]));
                u32x4 w; w.x = cvt_pk_bf16(v0[0], v0[1]); w.y = cvt_pk_bf16(v0[2], v0[3]); w.z = cvt_pk_bf16(v1[0], v1[1]); w.w = cvt_pk_bf16(v1[2], v1[3]);
                *(u32x4*)(H + off + bj * HALF) = w; }
            if (ssp) { ss = fq_sum(ss); if (fq == 0) ssp[(size_t)(row0 + ai * HALF + m * 16) * 16 + 4 * u.pn + wc] = ss; }
            asm volatile("" ::: "memory");
#pragma unroll
            for (int bj = 0; bj < 2; ++bj) hc[bj] = hn[bj];
        }
    }
};

__device__ __forceinline__ float logsig(float x) { return fminf(x, 0.f) - log1pf(expf(-fabsf(x))); }
struct EpiIn {
    static constexpr bool PERM = true, AFTER_DRAIN = false, STAGE = true; static constexpr bool CHAIN = false;
    PG8_LAS float* rsl;
    __device__ __forceinline__ void stage(const Unit& u, int wid, int lane) const { rs_stage(ssp, rsl, u, wid, lane); }
    bf16_t* O; const float* ssp; float* ffl; float* ig; float* lf; const float* bff; const float* bmi; const float* bmf;
    __device__ __forceinline__ void operator()(const f32x4 (&acc)[2][2][4][2], const Unit& u, int wr, int wc, int fr, int fq) const {
        const int pn = u.pn; const int row0 = u.pm * BM + wr * 64 + fr;
        float rsc[2][4]; rs_scale(rsc, rsl, wr, fr, fq);
        if (pn == 14) {
            if (wc == 0 && fq < 2) {
                f32x4 b0, b1;
                if (fq == 0) { b0 = *(const f32x4*)bff; b1 = *(const f32x4*)(bff + 4); } else { b0 = *(const f32x4*)bmi; b1 = *(const f32x4*)bmf; }
#pragma unroll
                for (int ai = 0; ai < 2; ++ai)
#pragma unroll
                    for (int m = 0; m < 4; ++m) { const size_t row = (size_t)(row0 + ai * HALF + m * 16); const f32x4 v0 = acc[ai][0][m][0] * rsc[ai][m] + b0, v1 = acc[ai][0][m][1] * rsc[ai][m] + b1;
                        if (fq == 0) { *(f32x4*)(ffl + row * 8) = (f32x4){logsig(v0[0]), logsig(v0[1]), logsig(v0[2]), logsig(v0[3])}; *(f32x4*)(ffl + row * 8 + 4) = (f32x4){logsig(v1[0]), logsig(v1[1]), logsig(v1[2]), logsig(v1[3])}; }
                        else { *(f32x4*)(ig + row * 4) = v0; *(f32x4*)(lf + row * 4) = (f32x4){logsig(v1[0]), logsig(v1[1]), logsig(v1[2]), logsig(v1[3])}; } }
            }
            return;
        }
        int slot, ld, colt;
        if (pn < 6) { slot = pn >> 1; ld = 512; colt = (pn & 1) * 256; }
        else if (pn < 10) { slot = 3; ld = 1024; colt = (pn - 6) * 256; }
        else { slot = 5 + ((pn - 10) >> 1); ld = 512; colt = ((pn - 10) & 1) * 256; }
        bf16_t* base = O + (size_t)slot * 33554432u;
        const int col0 = colt + wc * 32 + 8 * fq;
#pragma unroll
        for (int ai = 0; ai < 2; ++ai)
#pragma unroll
            for (int m = 0; m < 4; ++m) { const size_t roff = (size_t)(row0 + ai * HALF + m * 16) * ld + col0;
#pragma unroll
                for (int bj = 0; bj < 2; ++bj) { f32x4 v0 = acc[ai][bj][m][0] * rsc[ai][m], v1 = acc[ai][bj][m][1] * rsc[ai][m];
                    if (pn >= 12) { v0 = sigm4(v0); v1 = sigm4(v1); }
                    u32x4 w; w.x = cvt_pk_bf16(v0[0], v0[1]); w.y = cvt_pk_bf16(v0[2], v0[3]); w.z = cvt_pk_bf16(v1[0], v1[1]); w.w = cvt_pk_bf16(v1[2], v1[3]);
                    *(u32x4*)(base + roff + bj * HALF) = w; } }
    }
};

struct DiagOrder {
    int G, c; bool xk;
    __device__ __forceinline__ bool next(int i, Unit& u) const {
        const int L = i * G + c; if (L >= 256) return false;
        const int layer = L >> 6, rem = L & 63;
        if (xk) { u.pm = layer * 16 + (rem >> 2); u.pn = layer * 4 + (rem & 3); } else { u.pm = layer * 4 + (rem >> 4); u.pn = layer * 16 + (rem & 15); }
        return true;
    }
    __device__ __forceinline__ void a_ready(const Unit&) const {}
    __device__ __forceinline__ void done(const Unit&) const {}
    PG8_DEFAULT_BASES
};

struct GateOrder {
    StaticOrder so;
    __device__ __forceinline__ void init(int M, int G_, int c_) { so.init(M, 1024, G_, c_); }
    __device__ __forceinline__ bool next(int i, Unit& u) const { if (!so.next(i >> 1, u)) return false; u.pn += 4 * (i & 1); return true; }
    __device__ __forceinline__ void a_ready(const Unit&) const {}
    __device__ __forceinline__ void done(const Unit&) const {}
    PG8_DEFAULT_BASES
};

typedef unsigned u32x2 __attribute__((ext_vector_type(2)));
__device__ __forceinline__ unsigned pack_u8x4(f32x4 g) {
    const f32x4 t = __builtin_elementwise_roundeven(g * 255.0f);
    unsigned r = 0u;
    r = __builtin_amdgcn_cvt_pk_u8_f32(t[0], 0u, r); r = __builtin_amdgcn_cvt_pk_u8_f32(t[1], 1u, r); r = __builtin_amdgcn_cvt_pk_u8_f32(t[2], 2u, r); r = __builtin_amdgcn_cvt_pk_u8_f32(t[3], 3u, r);
    return r;
}
__device__ __forceinline__ f32x4 unpack_u8x4(unsigned w) {
    return (f32x4){(float)(w & 0xffu), (float)((w >> 8) & 0xffu), (float)((w >> 16) & 0xffu), (float)(w >> 24)};
}
struct EpiGate8 {
    static constexpr bool PERM = true, AFTER_DRAIN = false, STAGE = true; static constexpr bool CHAIN = false;
    unsigned char* G0; unsigned char* G1; const float* bias; const float* ssp; PG8_LAS float* rsl;
    __device__ __forceinline__ void stage(const Unit& u, int wid, int lane) const { rs_stage(ssp, rsl, u, wid, lane); }
    __device__ __forceinline__ void operator()(const f32x4 (&acc)[2][2][4][2], const Unit& u, int wr, int wc, int fr, int fq) const {
        unsigned char* base = (u.pn >> 2) ? G1 : G0; const int colt = (u.pn & 3) * BM;
        const int row0 = u.pm * BM + wr * 64 + fr, col0 = colt + wc * 32 + 8 * fq, bcol0 = u.pn * BM + wc * 32 + 8 * fq;
        f32x4 bv[2][2];
#pragma unroll
        for (int bj = 0; bj < 2; ++bj)
#pragma unroll
            for (int n = 0; n < 2; ++n) bv[bj][n] = *(const f32x4*)(bias + bcol0 + bj * HALF + 4 * n);
        float rsc[2][4]; rs_scale(rsc, rsl, wr, fr, fq);
#pragma unroll
        for (int ai = 0; ai < 2; ++ai)
#pragma unroll
            for (int m = 0; m < 4; ++m) { const size_t roff = (size_t)(row0 + ai * HALF + m * 16) * 1024 + colt + wc * 64 + 16 * fq;
                u32x4 w;
#pragma unroll
                for (int bj = 0; bj < 2; ++bj) { const f32x4 v0 = sigm4(acc[ai][bj][m][0] * rsc[ai][m] + bv[bj][0]), v1 = sigm4(acc[ai][bj][m][1] * rsc[ai][m] + bv[bj][1]);
                    if (bj == 0) { w.x = pack_u8x4(v0); w.y = pack_u8x4(v1); } else { w.z = pack_u8x4(v0); w.w = pack_u8x4(v1); } }
                *(u32x4*)(base + roff) = w; }
    }
};
template <bool ADD> struct EpiMerge8 {
    static constexpr bool PERM = true, AFTER_DRAIN = false, STAGE = false; static constexpr bool CHAIN = false;
    bf16_t* T; const unsigned char* G8;
    __device__ __forceinline__ void operator()(const f32x4 (&acc)[2][2][4][2], const Unit& u, int wr, int wc, int fr, int fq) const {
        const int row0 = u.pm * BM + wr * 64 + fr, col0 = u.pn * BM + wc * 32 + 8 * fq;
        u32x4 ga[8]; u32x4 tc[2], tn[2];
#pragma unroll
        for (int it = 0; it < 8; ++it) ga[it] = *(const u32x4*)(G8 + (size_t)(row0 + (it >> 2) * HALF + (it & 3) * 16) * 1024 + u.pn * BM + wc * 64 + 16 * fq);
        if (ADD) {
#pragma unroll
            for (int bj = 0; bj < 2; ++bj) tc[bj] = *(const u32x4*)(T + (size_t)row0 * 1024 + col0 + bj * HALF); }
#pragma unroll
        for (int it = 0; it < 8; ++it) { const int ai = it >> 2, m = it & 3; const size_t roff = (size_t)(row0 + ai * HALF + m * 16) * 1024 + col0;
            if (ADD && it < 7) { const size_t roff2 = (size_t)(row0 + ((it + 1) >> 2) * HALF + ((it + 1) & 3) * 16) * 1024 + col0;
#pragma unroll
                for (int bj = 0; bj < 2; ++bj) tn[bj] = *(const u32x4*)(T + roff2 + bj * HALF); }
            if (ADD) asm volatile("" ::: "memory");
#pragma unroll
            for (int bj = 0; bj < 2; ++bj) { f32x4 v0 = acc[ai][bj][m][0] * (unpack_u8x4(bj ? ga[it].z : ga[it].x) * (1.0f / 255.0f)), v1 = acc[ai][bj][m][1] * (unpack_u8x4(bj ? ga[it].w : ga[it].y) * (1.0f / 255.0f));
                if (ADD) { f32x4 t0, t1; unpack8(tc[bj], t0, t1); v0 = v0 + t0; v1 = v1 + t1; }
                u32x4 w; w.x = cvt_pk_bf16(v0[0], v0[1]); w.y = cvt_pk_bf16(v0[2], v0[3]); w.z = cvt_pk_bf16(v1[0], v1[1]); w.w = cvt_pk_bf16(v1[2], v1[3]);
                *(u32x4*)(T + roff + bj * HALF) = w; }
            if (ADD) { asm volatile("" ::: "memory");
#pragma unroll
                for (int bj = 0; bj < 2; ++bj) tc[bj] = tn[bj]; }
        }
    }
};

#ifndef SKEW_A
#define SKEW_A 9
#define SKEW_B 5
#endif
static_assert(24 * SKEW_A + 8 * SKEW_B == 256, "SkewOrder: 24 a + 8 b units per XCD");
struct SkewOrder {
    StaticOrder so; int G, c; bool skew;
    __device__ __forceinline__ void init(int M, int G_, int c_) { so.init(M, 2048, G_, c_); G = G_; c = c_; skew = (G_ == 256); }
    __device__ __forceinline__ bool next(int i, Unit& u) const {
        if (!skew) return so.next(i, u);
        const int x = c & 7, j = c >> 3; int lu;
        if ((j & 3) == 0) { if (i >= SKEW_B) return false; lu = 24 * SKEW_A + SKEW_B * (j >> 2) + i; }
        else { if (i >= SKEW_A) return false; lu = (j - (j >> 2) - 1) + 24 * i; }
        u.pm = 8 * (lu >> 3) + x; u.pn = lu & 7; return true;
    }
    __device__ __forceinline__ void a_ready(const Unit&) const {}
    __device__ __forceinline__ void done(const Unit&) const {}
    PG8_DEFAULT_BASES
};

struct BatchBOrder {
    StaticOrder so;
    __device__ __forceinline__ void init(int M, int N, int G_, int c_) { so.init(M, N, G_, c_); }
    __device__ __forceinline__ bool next(int i, Unit& u) const { return so.next(i, u); }
    __device__ __forceinline__ void a_ready(const Unit&) const {}
    __device__ __forceinline__ void done(const Unit&) const {}
    __device__ __forceinline__ const char* abase(const Gemm& g, const Unit& u) const { return (const char*)g.A + (size_t)u.pm * BM * g.lda * 2; }
    __device__ __forceinline__ const char* bbase(const Gemm& g, const Unit& u) const { return (const char*)g.Bt + ((size_t)(u.pm >> 4) * 1024 + (size_t)u.pn * BM) * g.ldb * 2; }
};
struct XPreOrder {
    int G, c; const bf16_t* A2; const bf16_t* B2;
    __device__ __forceinline__ bool next(int i, Unit& u) const { const int L = i * G + c; if (L >= 512) return false;
        if (L < 256) { u.pm = L >> 2; u.pn = L & 3; } else { const int L2 = L - 256; u.pm = 64 + (L2 >> 4) * 4 + ((L2 >> 2) & 3); u.pn = L2 & 3; } return true; }
    __device__ __forceinline__ void a_ready(const Unit&) const {}
    __device__ __forceinline__ void done(const Unit&) const {}
    __device__ __forceinline__ const char* abase(const Gemm& g, const Unit& u) const {
        if (u.pm < 64) return (const char*)g.A + ((size_t)(u.pm >> 2) * 256 * 1024 + (size_t)(u.pm & 3) * 256) * 2;
        return (const char*)A2 + ((size_t)(u.pm & 3) * 256 * 1024 + (size_t)u.pn * 256) * 2; }
    __device__ __forceinline__ const char* bbase(const Gemm& g, const Unit& u) const {
        if (u.pm < 64) return (const char*)g.Bt + ((size_t)u.pn * 256 * 1024 + (size_t)(u.pm & 3) * 256) * 2;
        return (const char*)B2 + ((size_t)((u.pm - 64) >> 2) * 256 * 1024 + (size_t)u.pn * 256) * 2; }
};
__device__ __forceinline__ float fq_max(float v) {
    { auto r = __builtin_amdgcn_permlane16_swap(__float_as_uint(v), __float_as_uint(v), false, false); v = fmaxf(__uint_as_float(r[0]), __uint_as_float(r[1])); }
    { auto r = __builtin_amdgcn_permlane32_swap(__float_as_uint(v), __float_as_uint(v), false, false); v = fmaxf(__uint_as_float(r[0]), __uint_as_float(r[1])); }
    return v;
}
struct EpiSoftmax {
    static constexpr bool PERM = true, AFTER_DRAIN = false, STAGE = true; static constexpr bool CHAIN = false;
    bf16_t* O; const float* ssp; PG8_LAS float* rsl; PG8_LAS float* red;
    __device__ __forceinline__ void stage(const Unit& u, int wid, int lane) const { rs_stage(ssp, rsl, u, wid, lane); }
    __device__ __forceinline__ void operator()(const f32x4 (&acc)[2][2][4][2], const Unit& u, int wr, int wc, int fr, int fq) const {
        float rsc[2][4]; rs_scale(rsc, rsl, wr, fr, fq);
        int rl0 = (wr * 64 + fr) * 8; asm volatile("" : "+v"(rl0));
        float mw[2][4];
#pragma unroll
        for (int ai = 0; ai < 2; ++ai)
#pragma unroll
            for (int m = 0; m < 4; ++m) { float t = -INFINITY;
#pragma unroll
                for (int bj = 0; bj < 2; ++bj)
#pragma unroll
                    for (int n = 0; n < 2; ++n) { const f32x4 v = acc[ai][bj][m][n] * rsc[ai][m]; t = fmaxf(fmaxf(t, fmaxf(v[0], v[1])), fmaxf(v[2], v[3])); }
                t = fq_max(t); mw[ai][m] = t;
                float s = 0.f;
#pragma unroll
                for (int bj = 0; bj < 2; ++bj)
#pragma unroll
                    for (int n = 0; n < 2; ++n) { const f32x4 v = acc[ai][bj][m][n] * rsc[ai][m] - t;
                        s += (__builtin_amdgcn_exp2f(v[0]) + __builtin_amdgcn_exp2f(v[1])) + (__builtin_amdgcn_exp2f(v[2]) + __builtin_amdgcn_exp2f(v[3])); }
                s = fq_sum(s);
                if (fq == 0) { typedef float f32x2 __attribute__((ext_vector_type(2))); *(PG8_LAS f32x2*)(red + rl0 + (ai * HALF + m * 16) * 8 + 2 * wc) = (f32x2){t, s}; } }
        asm volatile("s_waitcnt lgkmcnt(0)" ::: "memory"); __builtin_amdgcn_s_barrier(); asm volatile("" ::: "memory");
        const int row0 = u.pm * BM + wr * 64 + fr, col0 = u.pn * BM + wc * 32 + 8 * fq;
#pragma unroll
        for (int ai = 0; ai < 2; ++ai)
#pragma unroll
            for (int m = 0; m < 4; ++m) { const f32x4 qa = *(const PG8_LAS f32x4*)(red + rl0 + (ai * HALF + m * 16) * 8), qb = *(const PG8_LAS f32x4*)(red + rl0 + (ai * HALF + m * 16) * 8 + 4);
                const float mm = fmaxf(fmaxf(qa[0], qa[2]), fmaxf(qb[0], qb[2]));
                const float l = (qa[1] * __builtin_amdgcn_exp2f(qa[0] - mm) + qa[3] * __builtin_amdgcn_exp2f(qa[2] - mm)) + (qb[1] * __builtin_amdgcn_exp2f(qb[0] - mm) + qb[3] * __builtin_amdgcn_exp2f(qb[2] - mm));
                float inv; asm("v_rcp_f32_e32 %0, %1" : "=v"(inv) : "v"(l));
                const float f = __builtin_amdgcn_exp2f(mw[ai][m] - mm) * inv, t = mw[ai][m];
                const size_t roff = (size_t)(row0 + ai * HALF + m * 16) * 1024 + col0;
#pragma unroll
                for (int bj = 0; bj < 2; ++bj) { const f32x4 v0 = acc[ai][bj][m][0] * rsc[ai][m] - t, v1 = acc[ai][bj][m][1] * rsc[ai][m] - t;
                    u32x4 w; w.x = cvt_pk_bf16(__builtin_amdgcn_exp2f(v0[0]) * f, __builtin_amdgcn_exp2f(v0[1]) * f); w.y = cvt_pk_bf16(__builtin_amdgcn_exp2f(v0[2]) * f, __builtin_amdgcn_exp2f(v0[3]) * f);
                    w.z = cvt_pk_bf16(__builtin_amdgcn_exp2f(v1[0]) * f, __builtin_amdgcn_exp2f(v1[1]) * f); w.w = cvt_pk_bf16(__builtin_amdgcn_exp2f(v1[2]) * f, __builtin_amdgcn_exp2f(v1[3]) * f);
                    *(u32x4*)(O + roff + bj * HALF) = w; } }
    }
};

struct ChainOrder {
    StaticOrder so; const bf16_t* A2; const bf16_t* B2;
    __device__ __forceinline__ void init(int M, int N, int G_, int c_) { so.init(M, N, G_, c_); }
    __device__ __forceinline__ bool next(int i, Unit& u) const { if (!so.next(i >> 1, u)) return false; u.pn |= (i & 1) << 8; return true; }
    __device__ __forceinline__ void a_ready(const Unit&) const {}
    __device__ __forceinline__ void done(const Unit&) const {}
    __device__ __forceinline__ const char* abase(const Gemm& g, const Unit& u) const { return (const char*)((u.pn >> 8) ? A2 : g.A) + (size_t)u.pm * BM * g.lda * 2; }
    __device__ __forceinline__ const char* bbase(const Gemm& g, const Unit& u) const { return (const char*)((u.pn >> 8) ? B2 : g.Bt) + (size_t)(u.pn & 255) * BM * g.ldb * 2; }
};
struct EpiChain {
    static constexpr bool PERM = true, AFTER_DRAIN = false, STAGE = false, CHAIN = true;
    bf16_t* T; const unsigned char* Gf; const unsigned char* Gm;
    static __device__ __forceinline__ f32x4 den4(unsigned w) { const f32x4 g = unpack_u8x4(w); return (f32x4){fmaxf(g[0], 1.f), fmaxf(g[1], 1.f), fmaxf(g[2], 1.f), fmaxf(g[3], 1.f)}; }
    static __device__ __forceinline__ f32x4 rcp4(f32x4 d) { f32x4 r; asm("v_rcp_f32_e32 %0, %1" : "=v"(r[0]) : "v"(d[0])); asm("v_rcp_f32_e32 %0, %1" : "=v"(r[1]) : "v"(d[1])); asm("v_rcp_f32_e32 %0, %1" : "=v"(r[2]) : "v"(d[2])); asm("v_rcp_f32_e32 %0, %1" : "=v"(r[3]) : "v"(d[3])); return r; }
    __device__ __forceinline__ void mid(f32x4 (&acc)[2][2][4][2], const Unit& u, int wr, int wc, int fr, int fq) const {
        const int row0 = u.pm * BM + wr * 64 + fr, gcol = (u.pn & 255) * BM + wc * 64 + 16 * fq;
        u32x4 gf[8], gm[8];
#pragma unroll
        for (int it = 0; it < 8; ++it) { const size_t o = (size_t)(row0 + (it >> 2) * HALF + (it & 3) * 16) * 1024 + gcol; gf[it] = *(const u32x4*)(Gf + o); gm[it] = *(const u32x4*)(Gm + o); }
#pragma unroll
        for (int it = 0; it < 8; ++it) { const int ai = it >> 2, m = it & 3;
#pragma unroll
            for (int bj = 0; bj < 2; ++bj) {
                acc[ai][bj][m][0] = acc[ai][bj][m][0] * (unpack_u8x4(bj ? gf[it].z : gf[it].x) * rcp4(den4(bj ? gm[it].z : gm[it].x)));
                acc[ai][bj][m][1] = acc[ai][bj][m][1] * (unpack_u8x4(bj ? gf[it].w : gf[it].y) * rcp4(den4(bj ? gm[it].w : gm[it].y))); } }
    }
    __device__ __forceinline__ void operator()(const f32x4 (&acc)[2][2][4][2], const Unit& u, int wr, int wc, int fr, int fq) const {
        const int row0 = u.pm * BM + wr * 64 + fr, pn = u.pn & 255, col0 = pn * BM + wc * 32 + 8 * fq, gcol = pn * BM + wc * 64 + 16 * fq;
        u32x4 gm[8];
#pragma unroll
        for (int it = 0; it < 8; ++it) gm[it] = *(const u32x4*)(Gm + (size_t)(row0 + (it >> 2) * HALF + (it & 3) * 16) * 1024 + gcol);
#pragma unroll
        for (int it = 0; it < 8; ++it) { const int ai = it >> 2, m = it & 3; const size_t roff = (size_t)(row0 + ai * HALF + m * 16) * 1024 + col0;
#pragma unroll
            for (int bj = 0; bj < 2; ++bj) { const f32x4 v0 = acc[ai][bj][m][0] * (den4(bj ? gm[it].z : gm[it].x) * (1.0f / 255.0f)), v1 = acc[ai][bj][m][1] * (den4(bj ? gm[it].w : gm[it].y) * (1.0f / 255.0f));
                u32x4 w; w.x = cvt_pk_bf16(v0[0], v0[1]); w.y = cvt_pk_bf16(v0[2], v0[3]); w.z = cvt_pk_bf16(v1[0], v1[1]); w.w = cvt_pk_bf16(v1[2], v1[3]);
                *(u32x4*)(T + roff + bj * HALF) = w; } }
    }
};
template <class Epi, class Sched, bool ALIGN_EPI = false, bool SP2 = false>
__device__ __forceinline__ void gemm_phase(PG8_LAS unsigned char* lds, const Gemm g, const Sched& S, const Epi& E) {
    int tid_ = threadIdx.x; asm volatile("" : "+v"(tid_));
    const int tid = tid_, wid = __builtin_amdgcn_readfirstlane(tid >> 6), lane = tid & 63, wr = wid >> 2, wc = wid & 3, fr = lane & 15, fq = lane >> 4;
    const int K = g.K, nt = K / BK;
    unsigned voffA[2], voffB[2];
#pragma unroll
    for (int i = 0; i < 2; ++i) { int R, C; stage_rc(tid * 16 + i * 8192, R, C); const int Rb = Epi::PERM ? ((R & ~31) + perm32(R & 31)) : R;
        voffA[i] = (unsigned)(R * g.lda + C) * 2u; voffB[i] = (unsigned)(Rb * g.ldb + C) * 2u; }
    const size_t kstep = (size_t)(BK * 2);
    const size_t hstepA = (size_t)HALF * g.lda * 2, hstepB = (size_t)HALF * g.ldb * 2;
    const unsigned ldsw = (unsigned)wid * 1024u;
    const int aoff = lds_byte(wr * 64 + fr, fq * 8), boff = lds_byte(wc * 32 + fr, fq * 8);
#define PG8_SA(b, h) (((b) * 2 + (h)) * HTB)
#define PG8_SB(b, h) ((4 + (b) * 2 + (h)) * HTB)
#define PG8_STAGE(bufoff, gbase, voff) do { _Pragma("unroll") for (int _i = 0; _i < 2; ++_i) \
        __builtin_amdgcn_global_load_lds((const unsigned*)((const char*)(gbase) + (voff)[_i]), (PG8_LAS unsigned*)(lds + (bufoff) + ldsw + _i * 8192), 16, 0, 0); } while (0)
#define PG8_LDA(dst, b, h) do { _Pragma("unroll") for (int m = 0; m < 4; ++m) _Pragma("unroll") for (int k = 0; k < 2; ++k) dst[m][k] = *(const PG8_LAS bf16x8*)(lds + PG8_SA(b, h) + aoff + m * 2048 + k * 1024); } while (0)
#define PG8_LDB(dst, b, h) do { _Pragma("unroll") for (int n = 0; n < 2; ++n) _Pragma("unroll") for (int k = 0; k < 2; ++k) dst[n][k] = *(const PG8_LAS bf16x8*)(lds + PG8_SB(b, h) + boff + n * 2048 + k * 1024); } while (0)
#define PG8_MMA(ai, bj, At, Bt) do { __builtin_amdgcn_s_setprio(1); _Pragma("unroll") for (int m = 0; m < 4; ++m) _Pragma("unroll") for (int n = 0; n < 2; ++n) _Pragma("unroll") for (int k = 0; k < 2; ++k) \
        acc[ai][bj][m][n] = __builtin_amdgcn_mfma_f32_16x16x32_bf16(Bt[n][k], At[m][k], acc[ai][bj][m][n], 0, 0, 0); __builtin_amdgcn_s_setprio(0); } while (0)
#define PG8_WAIT_V(n) asm volatile("s_waitcnt vmcnt(" #n ")" ::: "memory")
#define PG8_WAIT_L(n) asm volatile("s_waitcnt lgkmcnt(" #n ")" ::: "memory")
#define PG8_BAR __builtin_amdgcn_s_barrier()
#define PG8_SCHED __builtin_amdgcn_sched_barrier(0)
    Unit cur, nxt; int ui = 0;
    if (!S.next(0, cur)) return;
    f32x4 acc[2][2][4][2];
#pragma unroll
    for (int a = 0; a < 2; ++a)
#pragma unroll
        for (int b = 0; b < 2; ++b)
#pragma unroll
            for (int m = 0; m < 4; ++m)
#pragma unroll
                for (int n = 0; n < 2; ++n) acc[a][b][m][n] = (f32x4){0.f, 0.f, 0.f, 0.f};
    bf16x8 At[4][2], B0[2][2], B1[2][2];
    const char* cA = S.abase(g, cur); const char* cB = S.bbase(g, cur);
    S.a_ready(cur);
    if constexpr (Epi::STAGE) { int t_s = threadIdx.x; asm volatile("" : "+v"(t_s)); E.stage(cur, wid, t_s & 63); }
    if constexpr (SP2) {
        PG8_STAGE(PG8_SB(0, 0), cB, voffB); PG8_STAGE(PG8_SB(0, 1), cB + hstepB, voffB); PG8_STAGE(PG8_SA(0, 0), cA, voffA); PG8_STAGE(PG8_SA(0, 1), cA + hstepA, voffA);
        if (wr == 1) PG8_BAR;
        PG8_WAIT_V(2); PG8_BAR;
        PG8_STAGE(PG8_SB(1, 0), cB + kstep, voffB); PG8_STAGE(PG8_SA(1, 0), cA + kstep, voffA); PG8_STAGE(PG8_SB(1, 1), cB + hstepB + kstep, voffB);
        PG8_WAIT_V(6); PG8_BAR;
    } else {
        PG8_STAGE(PG8_SB(0, 0), cB, voffB); PG8_STAGE(PG8_SA(0, 0), cA, voffA); PG8_STAGE(PG8_SB(0, 1), cB + hstepB, voffB); PG8_STAGE(PG8_SA(0, 1), cA + hstepA, voffA);
        if (wr == 1) PG8_BAR;
        PG8_WAIT_V(4); PG8_BAR;
        PG8_STAGE(PG8_SB(1, 0), cB + kstep, voffB); PG8_STAGE(PG8_SA(1, 0), cA + kstep, voffA); PG8_STAGE(PG8_SB(1, 1), cB + hstepB + kstep, voffB);
        PG8_WAIT_V(6); PG8_BAR;
    }
    for (;;) {
        const bool has_next = S.next(ui + 1, nxt);
        const char* nA = has_next ? S.abase(g, nxt) : cA; const char* nB = has_next ? S.bbase(g, nxt) : cB;
        for (int t = 0; t < nt; t += 2) {
            const bool last = (t == nt - 2);
            const char* a1 = cA + (size_t)(t + 1) * kstep;
            const char* a2 = last ? nA : cA + (size_t)(t + 2) * kstep; const char* b2 = last ? nB : cB + (size_t)(t + 2) * kstep;
            const char* a3 = a2 + kstep; const char* b3 = b2 + kstep;
            if (last && has_next) S.a_ready(nxt);
            if constexpr (SP2) {
            PG8_LDB(B0, 0, 0); PG8_LDB(B1, 0, 1); PG8_SCHED; PG8_LDA(At, 0, 0); PG8_STAGE(PG8_SA(1, 1), a1 + hstepA, voffA);
            PG8_WAIT_V(8); PG8_WAIT_L(0); PG8_BAR; PG8_MMA(0, 0, At, B0); PG8_MMA(0, 1, At, B1); PG8_BAR; PG8_SCHED;
            PG8_LDA(At, 0, 1); PG8_STAGE(PG8_SB(0, 0), b2, voffB); PG8_STAGE(PG8_SB(0, 1), b2 + hstepB, voffB); PG8_STAGE(PG8_SA(0, 0), a2, voffA);
            PG8_WAIT_V(8); PG8_WAIT_L(0); PG8_BAR; PG8_MMA(1, 0, At, B0); PG8_MMA(1, 1, At, B1); PG8_BAR; PG8_SCHED;
            PG8_LDB(B0, 1, 0); PG8_LDB(B1, 1, 1); PG8_SCHED; PG8_LDA(At, 1, 0); PG8_STAGE(PG8_SA(0, 1), a2 + hstepA, voffA);
            PG8_WAIT_V(8); PG8_WAIT_L(0); PG8_BAR; PG8_MMA(0, 0, At, B0); PG8_MMA(0, 1, At, B1); PG8_BAR; PG8_SCHED;
            PG8_LDA(At, 1, 1); PG8_STAGE(PG8_SB(1, 0), b3, voffB); PG8_STAGE(PG8_SB(1, 1), b3 + hstepB, voffB); PG8_STAGE(PG8_SA(1, 0), a3, voffA);
            PG8_WAIT_V(8); PG8_WAIT_L(0); PG8_BAR; PG8_MMA(1, 0, At, B0); PG8_MMA(1, 1, At, B1); PG8_BAR; PG8_SCHED;
            } else {
            PG8_LDB(B0, 0, 0); PG8_SCHED; PG8_LDA(At, 0, 0); PG8_STAGE(PG8_SA(1, 1), a1 + hstepA, voffA);
            PG8_WAIT_L(8); PG8_BAR; PG8_WAIT_L(0); PG8_MMA(0, 0, At, B0); PG8_BAR; PG8_SCHED;
            PG8_LDB(B1, 0, 1); PG8_STAGE(PG8_SB(0, 0), b2, voffB);
            PG8_BAR; PG8_WAIT_L(0); PG8_MMA(0, 1, At, B1); PG8_BAR;
            PG8_LDA(At, 0, 1); PG8_STAGE(PG8_SA(0, 0), a2, voffA);
            PG8_BAR; PG8_WAIT_L(0); PG8_MMA(1, 0, At, B0); PG8_BAR; PG8_SCHED;
            PG8_STAGE(PG8_SB(0, 1), b2 + hstepB, voffB);
            PG8_WAIT_V(6); PG8_BAR; PG8_MMA(1, 1, At, B1); PG8_BAR;
            PG8_LDB(B0, 1, 0); PG8_SCHED; PG8_LDA(At, 1, 0); PG8_STAGE(PG8_SA(0, 1), a2 + hstepA, voffA);
            PG8_WAIT_L(8); PG8_BAR; PG8_WAIT_L(0); PG8_MMA(0, 0, At, B0); PG8_BAR; PG8_SCHED;
            PG8_LDB(B1, 1, 1); PG8_STAGE(PG8_SB(1, 0), b3, voffB);
            PG8_BAR; PG8_WAIT_L(0); PG8_MMA(0, 1, At, B1); PG8_BAR;
            PG8_LDA(At, 1, 1); PG8_STAGE(PG8_SA(1, 0), a3, voffA);
            PG8_BAR; PG8_WAIT_L(0); PG8_MMA(1, 0, At, B0); PG8_BAR; PG8_SCHED;
            PG8_STAGE(PG8_SB(1, 1), b3 + hstepB, voffB);
            PG8_WAIT_V(6); PG8_BAR; PG8_MMA(1, 1, At, B1); PG8_BAR;
            }
        }
#if defined(PROBE_EPI)
        { volatile PG8_LAS unsigned* pm_ = (volatile PG8_LAS unsigned*)(lds + PROBE_MISC_OFF); if (tid == PROBE_EPI_TID && blockIdx.x == 0 && pm_[20]) { const unsigned long long t_ = __builtin_amdgcn_s_memrealtime(); pm_[22] = (unsigned)t_; pm_[23] = (unsigned)(t_ >> 32); } }
#endif
        if constexpr (ALIGN_EPI) { if (wr == 0) PG8_BAR; }
        if constexpr (!Epi::AFTER_DRAIN) { int t_e = threadIdx.x; asm volatile("" : "+v"(t_e));
            if constexpr (Epi::CHAIN) { if (cur.pn >> 8) E(acc, cur, wr, wc, t_e & 15, (t_e >> 4) & 3); else E.mid(acc, cur, wr, wc, t_e & 15, (t_e >> 4) & 3); }
            else E(acc, cur, wr, wc, t_e & 15, (t_e >> 4) & 3);
            S.done(cur); }
#if defined(PROBE_EPI)
        { volatile PG8_LAS unsigned* pm_ = (volatile PG8_LAS unsigned*)(lds + PROBE_MISC_OFF); if (tid == PROBE_EPI_TID && blockIdx.x == 0 && pm_[20]) { if (PROBE_EPI == 2) asm volatile("s_waitcnt vmcnt(0)" ::: "memory"); const unsigned long long d_ = __builtin_amdgcn_s_memrealtime() - ((unsigned long long)pm_[22] | ((unsigned long long)pm_[23] << 32)); pm_[16] = pm_[16] + (unsigned)d_; } }
#endif
        if (!has_next) break;
        if (!Epi::CHAIN || (cur.pn >> 8))
#pragma unroll
        for (int a = 0; a < 2; ++a)
#pragma unroll
            for (int b = 0; b < 2; ++b)
#pragma unroll
                for (int m = 0; m < 4; ++m)
#pragma unroll
                    for (int n = 0; n < 2; ++n) acc[a][b][m][n] = (f32x4){0.f, 0.f, 0.f, 0.f};
        cur = nxt; cA = nA; cB = nB; ++ui;
        if constexpr (Epi::STAGE) { PG8_WAIT_L(0); PG8_BAR; int t_s = threadIdx.x; asm volatile("" : "+v"(t_s)); E.stage(cur, wid, t_s & 63); }
        if constexpr (ALIGN_EPI) { if (wr == 1) PG8_BAR; }
    }
    PG8_WAIT_V(0);
    if constexpr (!ALIGN_EPI) { if (wr == 0) PG8_BAR; }
    PG8_BAR;
    if constexpr (Epi::AFTER_DRAIN) { E.fused(acc, cur, wr, wc, fr, fq, lds, wid, lane); S.done(cur); }
#undef PG8_SA
#undef PG8_SB
#undef PG8_STAGE
#undef PG8_LDA
#undef PG8_LDB
#undef PG8_MMA
#undef PG8_WAIT_V
#undef PG8_WAIT_L
#undef PG8_BAR
#undef PG8_SCHED
}
}
#include <hip/hip_bf16.h>
#include <cmath>
namespace attn_body {
using bf16=__hip_bfloat16;
using bf16x8=__attribute__((ext_vector_type(8)))short;
using s16x4=__attribute__((ext_vector_type(4)))short;
using f32x16=__attribute__((ext_vector_type(16)))float;
using u32x4=__attribute__((ext_vector_type(4)))unsigned;
using f32x4_t=__attribute__((ext_vector_type(4)))float;
constexpr int BATCH=16,NHEAD=8,SEQ=4096,D=64,DM=NHEAD*D;
constexpr int NW=8,QBLK=32,QB=QBLK*NW,KVBLK=64,NQB=SEQ/QB;
constexpr int ATTN_PITCH=DM, ATTN_UNIT_ROWS=QB;
__device__ __forceinline__ int crow(int r,int hi){return (r&3)+8*(r>>2)+4*hi;}
#define SBAR() __builtin_amdgcn_sched_barrier(0)
__device__ __forceinline__ void cmask(f32x16&p0,f32x16&p1,int jb,int qrel,int hi){
  const float NEG=-INFINITY; int kb=64*jb+4*hi;
  #pragma unroll
  for(int r=0;r<16;++r){int kv=kb+(r&3)+8*(r>>2); if(kv>qrel)p0[r]=NEG; if(kv+32>qrel)p1[r]=NEG;}
}

constexpr int NSLOT=3, SLOTB=8192;
constexpr int LDS_K=0, LDS_V=NSLOT*SLOTB, LDS_WS=2*NSLOT*SLOTB, LDS_OST=LDS_WS+NW*64*4, LDS_CB=LDS_OST+NW*4096, LDS_BYTES=LDS_CB+SEQ*4;
constexpr float C2=0.125f*1.4426950408889634f;
__device__ __forceinline__ void glds16(const void*gsrc,unsigned lds_dst){unsigned keep;
  asm volatile("s_mov_b32 %0, m0\n\ts_mov_b32 m0, %2\n\ts_nop 0\n\tglobal_load_lds_dwordx4 %1, off\n\ts_mov_b32 m0, %0":"=&s"(keep):"v"(gsrc),"s"(lds_dst):"memory");}
__device__ __forceinline__ float max3f(float a,float b,float c){float r;asm("v_max3_f32 %0, %1, %2, %3":"=v"(r):"v"(a),"v"(b),"v"(c));return r;}
__device__ __forceinline__ float max2f(float a,float b){float r;asm("v_max_f32_e32 %0, %1, %2":"=v"(r):"v"(a),"v"(b));return r;}
__device__ __forceinline__ float fadd_s(float a,float b){float r;asm("v_add_f32_e32 %0, %1, %2":"=v"(r):"v"(a),"v"(b));return r;}
__device__ __forceinline__ float fsub_s(float a,float b){float r;asm("v_sub_f32_e32 %0, %1, %2":"=v"(r):"v"(a),"v"(b));return r;}
typedef float f32x2_t __attribute__((ext_vector_type(2))); typedef __bf16 bf16x2_t __attribute__((ext_vector_type(2)));
__device__ __forceinline__ unsigned cvtpk_s(float lo,float hi){f32x2_t v={lo,hi};bf16x2_t b=__builtin_convertvector(v,bf16x2_t);return __builtin_bit_cast(unsigned,b);}
#define WAIT_BAR(N) asm volatile("s_waitcnt vmcnt(" #N ") lgkmcnt(0)\n\ts_barrier":::"memory")

__device__ __forceinline__ void qkt(f32x16&p0,f32x16&p1,const char*Kslot,const bf16x8*qr,int r32,int hi){
  const char*kb=Kslot+hi*1024+r32*16;
  #pragma unroll
  for(int d0=0;d0<4;++d0){
    const bf16x8 b0=*reinterpret_cast<const bf16x8*>(kb+d0*2048);
    const bf16x8 b1=*reinterpret_cast<const bf16x8*>(kb+d0*2048+512);
    p0=__builtin_amdgcn_mfma_f32_32x32x16_bf16(b0,qr[d0],p0,0,0,0);p1=__builtin_amdgcn_mfma_f32_32x32x16_bf16(b1,qr[d0],p1,0,0,0);}
}
typedef __attribute__((address_space(3))) const char* lds_cptr;
typedef short v4i16_t __attribute__((ext_vector_type(4)));
__device__ __forceinline__ void kload8(bf16x8*kf,lds_cptr kp){
  kf[0]=*(const __attribute__((address_space(3))) bf16x8*)(kp);      kf[1]=*(const __attribute__((address_space(3))) bf16x8*)(kp+512);
  kf[2]=*(const __attribute__((address_space(3))) bf16x8*)(kp+2048); kf[3]=*(const __attribute__((address_space(3))) bf16x8*)(kp+2560);
  kf[4]=*(const __attribute__((address_space(3))) bf16x8*)(kp+4096); kf[5]=*(const __attribute__((address_space(3))) bf16x8*)(kp+4608);
  kf[6]=*(const __attribute__((address_space(3))) bf16x8*)(kp+6144); kf[7]=*(const __attribute__((address_space(3))) bf16x8*)(kp+6656);
}
__device__ __forceinline__ void kload2(bf16x8*kf,lds_cptr kp,int j){ kf[2*j]=*(const __attribute__((address_space(3))) bf16x8*)(kp+j*2048); kf[2*j+1]=*(const __attribute__((address_space(3))) bf16x8*)(kp+j*2048+512); }
__device__ __forceinline__ s16x4 vtr(lds_cptr p){ return __builtin_bit_cast(s16x4,__builtin_amdgcn_ds_read_tr16_b64_v4i16((__attribute__((address_space(3))) v4i16_t*)p)); }
__device__ __forceinline__ float rowmax(const f32x16&p0,const f32x16&p1){
  float a=max3f(p0[0],p0[1],p1[0]),b=max3f(p0[2],p0[3],p1[1]);a=max3f(a,p1[2],p1[3]);
  #pragma unroll
  for(int r=4;r<16;r+=4){a=max3f(a,p0[r],p0[r+1]);b=max3f(b,p0[r+2],p0[r+3]);a=max3f(a,p1[r],p1[r+1]);b=max3f(b,p1[r+2],p1[r+3]);}
  const float m=max2f(a,b);
  auto rr=__builtin_amdgcn_permlane32_swap(__float_as_uint(m),__float_as_uint(m),false,false);
  return max2f(__uint_as_float(rr[0]),__uint_as_float(rr[1]));
}
__device__ __forceinline__ void pv(f32x16*o,int vb,bf16x8 pa0,bf16x8 pa1,bf16x8 pa2,bf16x8 pa3){
  #pragma unroll
  for(int d0=0;d0<2;++d0){s16x4 lo[4],hi[4];
    #pragma unroll
    for(int ks=0;ks<4;++ks){
      asm volatile("ds_read_b64_tr_b16 %0,%1 offset:%c2":"=&v"(lo[ks]):"v"(vb),"i"(d0*4096+ks*1024):"memory");
      asm volatile("ds_read_b64_tr_b16 %0,%1 offset:%c2":"=&v"(hi[ks]):"v"(vb),"i"(d0*4096+ks*1024+512):"memory");}
    asm volatile("s_waitcnt lgkmcnt(0)":::"memory");SBAR();
    #define PK(k) (bf16x8){lo[k][0],lo[k][1],lo[k][2],lo[k][3],hi[k][0],hi[k][1],hi[k][2],hi[k][3]}
    o[d0]=__builtin_amdgcn_mfma_f32_32x32x16_bf16(pa0,PK(0),o[d0],0,0,0);
    o[d0]=__builtin_amdgcn_mfma_f32_32x32x16_bf16(pa1,PK(1),o[d0],0,0,0);
    o[d0]=__builtin_amdgcn_mfma_f32_32x32x16_bf16(pa2,PK(2),o[d0],0,0,0);
    o[d0]=__builtin_amdgcn_mfma_f32_32x32x16_bf16(pa3,PK(3),o[d0],0,0,0);
    #undef PK
  }
}

#ifndef ATTN_STORE16
#define ATTN_STORE16(p,v) (*(u32x4*)(p)=(v))
#endif
template<int THRL> __device__ __forceinline__ void attn_unit(int b,int h,int qb,const bf16*Q,const bf16*__restrict__ K,const bf16*__restrict__ V,bf16*O,char*shm,const float*CBg=nullptr){
  int tid_=threadIdx.x; asm volatile("":"+v"(tid_));
  const int tid=tid_,lane=tid&63,r32=lane&31,hi=lane>>5; const int wid=__builtin_amdgcn_readfirstlane(tid>>6);
  const long rowbase=(long)b*SEQ; const int q0=qb*QB;
  const bf16*Qw=Q+(rowbase+q0+wid*QBLK)*DM+h*D;
  const bf16*Kh=K+rowbase*DM+h*D,*Vh=V+rowbase*DM+h*D;
  const unsigned lds0=(unsigned)(uintptr_t)shm;
  float*wsf=(float*)(shm+LDS_WS)+wid*64;
  const bf16*ksrc=Kh+(long)lane*DM+wid*8;
  const bf16*vsrc=Vh+(long)(16*(wid&3)+(lane>>2))*DM+(wid>>2)*32+(lane&3)*8;
  const unsigned kdst=lds0+LDS_K+wid*1024, vdst=lds0+LDS_V+wid*1024;
  #define DMA_K(t,slot) glds16(ksrc+(long)(t)*KVBLK*DM,(unsigned)__builtin_amdgcn_readfirstlane(kdst+(slot)))
  #define DMA_V(t,slot) glds16(vsrc+(long)(t)*KVBLK*DM,(unsigned)__builtin_amdgcn_readfirstlane(vdst+(slot)))
  const int vb0=(int)(lds0+LDS_V)+((lane>>4)&1)*32+(lane&3)*8+(4*hi+((lane&15)>>2))*64;
  const char*Kbase=shm+LDS_K; bf16x8 kf[8];
  const lds_cptr shm3=(lds_cptr)shm; const lds_cptr kp0=shm3+LDS_K+hi*1024+r32*16; const lds_cptr vp0=shm3+LDS_V+((lane>>4)&1)*32+(lane&3)*8+(4*hi+((lane&15)>>2))*64;
  const int NT=(q0+QB)/KVBLK;
  DMA_K(0,0);DMA_V(0,0);DMA_K(1,SLOTB);
  bf16x8 qr[4];
  #pragma unroll
  for(int d0=0;d0<4;++d0)qr[d0]=*reinterpret_cast<const bf16x8*>(&Qw[(long)r32*DM+d0*16+hi*8]);
  float l_reg=0.f;f32x16 o[2];o[0]=f32x16{};o[1]=f32x16{};
  typedef __attribute__((address_space(3))) const float* lds_fptr; const lds_fptr cbt=(lds_fptr)(shm3+LDS_CB)+4*hi;
  float negcq;
  #define CBINIT(P0,P1,tt) do{ _Pragma("unroll") for(int g_=0;g_<4;++g_){ const f32x4_t a_=*(const __attribute__((address_space(3))) f32x4_t*)(cbt+64*(tt)+8*g_), b_=*(const __attribute__((address_space(3))) f32x4_t*)(cbt+64*(tt)+32+8*g_); \
      P0[4*g_]=a_[0]+negcq;P0[4*g_+1]=a_[1]+negcq;P0[4*g_+2]=a_[2]+negcq;P0[4*g_+3]=a_[3]+negcq; P1[4*g_]=b_[0]+negcq;P1[4*g_+1]=b_[1]+negcq;P1[4*g_+2]=b_[2]+negcq;P1[4*g_+3]=b_[3]+negcq; } }while(0)
  const int qrel=wid*QBLK+r32;
  #define CMASK(P0,P1,t) do{int jb_=(t)-(NT-4); if(jb_>=0)cmask(P0,P1,jb_,qrel,hi);}while(0)
  bool resc=false;
  #define START(P0,P1) do{ const float rm=rowmax(P0,P1); resc=false; \
    { const float dl=__builtin_fmaxf(rm,0.f); negcq=fsub_s(negcq,dl);     \
      _Pragma("unroll") for(int r=0;r<16;++r){P0[r]=fsub_s(P0[r],dl);P1[r]=fsub_s(P1[r],dl);} } \
    _Pragma("unroll") for(int r=0;r<16;++r)P0[r]=__builtin_amdgcn_exp2f(P0[r]); }while(0)
  #define RESC() do{ if(resc){ asm volatile("s_waitcnt lgkmcnt(0)":::"memory"); \
      _Pragma("unroll") for(int d_=0;d_<2;++d_) _Pragma("unroll") for(int r=0;r<16;++r)o[d_][r]*=wsf[crow(r,hi)]; } }while(0)
  f32x16 pA0,pA1,pB0,pB1;
  int sl_prev=0,sl_cur=0,sl_next=SLOTB;
  #define ROT() do{sl_prev=sl_cur;sl_cur=sl_next;sl_next=(sl_next==(NSLOT-1)*SLOTB)?0:sl_next+SLOTB;}while(0)
  DMA_K(2,2*SLOTB);
  if(CBg){ const f32x4_t*src=reinterpret_cast<const f32x4_t*>(CBg); f32x4_t*dst=reinterpret_cast<f32x4_t*>(shm+LDS_CB);
    #pragma unroll
    for(int k=0;k<SEQ/4/512;++k){ const int i_=tid+512*k; if(i_<NT*16)dst[i_]=src[i_]; } }
  WAIT_BAR(3);
  negcq=-((lds_fptr)(shm3+LDS_CB))[q0+wid*QBLK+r32];
  CBINIT(pA0,pA1,0);
  qkt(pA0,pA1,Kbase,qr,r32,hi);asm volatile("s_nop 15\n\ts_nop 7":"+v"(pA0),"+v"(pA1));CMASK(pA0,pA1,0);
  START(pA0,pA1);
  CBINIT(pB0,pB1,1);
  _Pragma("unroll") for(int r=0;r<16;++r)pA1[r]=__builtin_amdgcn_exp2f(pA1[r]);
  WAIT_BAR(0);
  DMA_K(3,0);DMA_V(1,SLOTB);
  ROT();
  kload8(kf,kp0+sl_cur);
  WAIT_BAR(2);
  s16x4 vlo[8],vhi[8]; u32x4 pw0,pw1,pw2,pw3;
  #define PKW(P,B) cvtpk_s(P[B],P[B+1])
  #define PAF(k) __builtin_bit_cast(bf16x8,pw##k)
  #define VFR(i) (bf16x8){vlo[i][0],vlo[i][1],vlo[i][2],vlo[i][3],vhi[i][0],vhi[i][1],vhi[i][2],vhi[i][3]}
  #define PIN(x) asm volatile("":"+v"(x))
  #define MX3(a,b,c) __builtin_fmaxf(__builtin_fmaxf((a),(b)),(c))
  #define GAPA(MF,A0,A1,A2,A3,W0,W1,PW) do{ MF; sacc+=A0; sacc+=A1; sacc+=A2; sacc+=A3; PIN(sacc); W0; W1; PIN(PW); SBAR(); }while(0)
  #define EX(v) __builtin_amdgcn_exp2f(v)
  #define GAPB(MF,X,B,G,Y,YB) do{ MF; X[B]=EX(X[B]); X[B+1]=EX(X[B+1]); X[B+2]=EX(X[B+2]); X[B+3]=EX(X[B+3]); PIN(X); if(G){ Y[YB]+=negcq; Y[YB+1]+=negcq; Y[YB+2]+=negcq; Y[YB+3]+=negcq; PIN(Y); } SBAR(); }while(0)
  #define CBLD(P0,P1,tt) do{ _Pragma("unroll") for(int g_=0;g_<4;++g_){ const f32x4_t a_=*(const __attribute__((address_space(3))) f32x4_t*)(cbt+64*(tt)+8*g_), b_=*(const __attribute__((address_space(3))) f32x4_t*)(cbt+64*(tt)+32+8*g_); \
      P0[4*g_]=a_[0];P0[4*g_+1]=a_[1];P0[4*g_+2]=a_[2];P0[4*g_+3]=a_[3]; P1[4*g_]=b_[0];P1[4*g_+1]=b_[1];P1[4*g_+2]=b_[2];P1[4*g_+3]=b_[3]; } }while(0)
  #define VRD(i) do{ vlo[i]=vtr(vp_+(((i)>>2)*4096+((i)&3)*1024)); vhi[i]=vtr(vp_+(((i)>>2)*4096+((i)&3)*1024+512)); }while(0)
  #define KRD(G,j) do{ if(G){ kload2(kf,kp0+sl_next,j); SBAR(); } }while(0)
  #define STEP(C0,C1,P0,P1,t,GK,GV,GL) do{ SBAR(); \
    const lds_cptr vp_=vp0+sl_prev; \
    VRD(0); SBAR(); float sacc=(P0[0]+P0[1]); \
    GAPA(C0=__builtin_amdgcn_mfma_f32_32x32x16_bf16(kf[0],qr[0],C0,0,0,0), P0[2],P0[3],P0[4],P0[5],     pw0[0]=PKW(P0,0), pw0[1]=PKW(P0,2), pw0); \
    VRD(4); SBAR(); GAPA(C1=__builtin_amdgcn_mfma_f32_32x32x16_bf16(kf[1],qr[0],C1,0,0,0), P0[6],P0[7],P0[8],P0[9],     pw0[2]=PKW(P0,4), pw0[3]=PKW(P0,6), pw0); \
    VRD(1); SBAR(); GAPA(C0=__builtin_amdgcn_mfma_f32_32x32x16_bf16(kf[2],qr[1],C0,0,0,0),   P0[10],P0[11],P0[12],P0[13], pw1[0]=PKW(P0,8), pw1[1]=PKW(P0,10), pw1); \
    VRD(5); SBAR(); GAPA(C1=__builtin_amdgcn_mfma_f32_32x32x16_bf16(kf[3],qr[1],C1,0,0,0),   P0[14],P0[15],P1[0],P1[1],   pw1[2]=PKW(P0,12),pw1[3]=PKW(P0,14), pw1); \
    VRD(2); SBAR(); GAPA(C0=__builtin_amdgcn_mfma_f32_32x32x16_bf16(kf[4],qr[2],C0,0,0,0),   P1[2],P1[3],P1[4],P1[5],     pw2[0]=PKW(P1,0), pw2[1]=PKW(P1,2), pw2); \
    VRD(6); SBAR(); GAPA(C1=__builtin_amdgcn_mfma_f32_32x32x16_bf16(kf[5],qr[2],C1,0,0,0),   P1[6],P1[7],P1[8],P1[9],     pw2[2]=PKW(P1,4), pw2[3]=PKW(P1,6), pw2); \
    VRD(3); SBAR(); GAPA(C0=__builtin_amdgcn_mfma_f32_32x32x16_bf16(kf[6],qr[3],C0,0,0,0),   P1[10],P1[11],P1[12],P1[13], pw3[0]=PKW(P1,8), pw3[1]=PKW(P1,10), pw3); \
    VRD(7); SBAR(); GAPA(C1=__builtin_amdgcn_mfma_f32_32x32x16_bf16(kf[7],qr[3],C1,0,0,0),   P1[14],P1[15],0.f,0.f,       pw3[2]=PKW(P1,12),pw3[3]=PKW(P1,14), pw3); \
    l_reg+=sacc; \
    if(GK){DMA_K((t)+3,sl_cur);} if(GV){DMA_V((t)+1,sl_next);} \
    CMASK(C0,C1,t); \
    { float a=MX3(C0[0],C0[1],C1[0]),b=MX3(C0[2],C0[3],C1[1]); a=MX3(a,C1[2],C1[3]); \
      _Pragma("unroll") for(int r=4;r<16;r+=4){a=MX3(a,C0[r],C0[r+1]);b=MX3(b,C0[r+2],C0[r+3]);a=MX3(a,C1[r],C1[r+1]);b=MX3(b,C1[r+2],C1[r+3]);} \
      float rm=__builtin_fmaxf(a,b); { auto rr=__builtin_amdgcn_permlane32_swap(__float_as_uint(rm),__float_as_uint(rm),false,false); rm=__builtin_fmaxf(__uint_as_float(rr[0]),__uint_as_float(rr[1])); } \
      resc=false; \
      if(__builtin_expect(__any(rm>(float)THRL),0)){ const float dl=__builtin_fmaxf(rm,0.f); negcq-=dl; \
        _Pragma("unroll") for(int r=0;r<16;++r){C0[r]-=dl;C1[r]-=dl;} \
        const float f=__builtin_amdgcn_exp2f(-dl); l_reg*=f; if(hi==0)wsf[r32]=f; resc=true; } } \
    SBAR(); \
    if(GL){ CBLD(P0,P1,(t)+1); SBAR(); }     \
    GAPB(o[0]=__builtin_amdgcn_mfma_f32_32x32x16_bf16(PAF(0),VFR(0),o[0],0,0,0), C0,0, GL,P0,0); \
    GAPB(o[1]=__builtin_amdgcn_mfma_f32_32x32x16_bf16(PAF(0),VFR(4),o[1],0,0,0), C0,4, GL,P0,4); \
    KRD(GL,0); GAPB(o[0]=__builtin_amdgcn_mfma_f32_32x32x16_bf16(PAF(1),VFR(1),o[0],0,0,0), C0,8, GL,P0,8); \
    KRD(GL,1); GAPB(o[1]=__builtin_amdgcn_mfma_f32_32x32x16_bf16(PAF(1),VFR(5),o[1],0,0,0), C0,12, GL,P0,12); \
    KRD(GL,2); GAPB(o[0]=__builtin_amdgcn_mfma_f32_32x32x16_bf16(PAF(2),VFR(2),o[0],0,0,0), C1,0, GL,P1,0); \
    KRD(GL,3); GAPB(o[1]=__builtin_amdgcn_mfma_f32_32x32x16_bf16(PAF(2),VFR(6),o[1],0,0,0), C1,4, GL,P1,4); \
    GAPB(o[0]=__builtin_amdgcn_mfma_f32_32x32x16_bf16(PAF(3),VFR(3),o[0],0,0,0), C1,8, GL,P1,8); \
    GAPB(o[1]=__builtin_amdgcn_mfma_f32_32x32x16_bf16(PAF(3),VFR(7),o[1],0,0,0), C1,12, GL,P1,12); \
    }while(0)
  int t=1;
  #undef CMASK
  #define CMASK(P0,P1,t) do{}while(0)
  for(;t+5<NT;t+=2){
    STEP(pB0,pB1,pA0,pA1,t,true,true,true);     WAIT_BAR(2); RESC(); ROT();
    STEP(pA0,pA1,pB0,pB1,t+1,true,true,true);   WAIT_BAR(2); RESC(); ROT();
  }
  #undef CMASK
  #define CMASK(P0,P1,t) do{int jb_=(t)-(NT-4); if(jb_>=0)cmask(P0,P1,jb_,qrel,hi);}while(0)
  #define ENDW(tt) do{ if((tt)+3<NT){WAIT_BAR(2);} else if((tt)+2<NT){WAIT_BAR(1);} else {WAIT_BAR(0);} }while(0)
  for(;t+1<NT;t+=2){
    STEP(pB0,pB1,pA0,pA1,t,(t+3<NT),(t+1<NT),(t+1<NT));       ENDW(t);   RESC(); ROT();
    STEP(pA0,pA1,pB0,pB1,t+1,(t+4<NT),(t+2<NT),(t+2<NT));     ENDW(t+1); RESC(); ROT();
  }
  STEP(pB0,pB1,pA0,pA1,NT-1,false,false,false); RESC();
  { float sacc=pB0[0]+pB0[1]; _Pragma("unroll") for(int r=2;r<16;++r)sacc+=pB0[r]; _Pragma("unroll") for(int r=0;r<16;++r)sacc+=pB1[r]; l_reg+=sacc;
    pw0=(u32x4){PKW(pB0,0),PKW(pB0,2),PKW(pB0,4),PKW(pB0,6)};pw1=(u32x4){PKW(pB0,8),PKW(pB0,10),PKW(pB0,12),PKW(pB0,14)};pw2=(u32x4){PKW(pB1,0),PKW(pB1,2),PKW(pB1,4),PKW(pB1,6)};pw3=(u32x4){PKW(pB1,8),PKW(pB1,10),PKW(pB1,12),PKW(pB1,14)};
    SBAR(); pv(o,vb0+sl_cur,PAF(0),PAF(1),PAF(2),PAF(3)); }
  #undef PKW
  #undef PAF
  #undef VFR
  #undef PIN
  #undef MX3
  #undef GAPA
  #undef GAPB
  #undef EX
  #undef VRD
  #undef KRD
  #undef STEP
  #undef ENDW
  {auto rr=__builtin_amdgcn_permlane32_swap(__float_as_uint(l_reg),__float_as_uint(l_reg),false,false);l_reg=__uint_as_float(rr[0])+__uint_as_float(rr[1]);}
  if(hi==0)wsf[32+r32]=l_reg;asm volatile("s_waitcnt lgkmcnt(0)":::"memory");
  float rli[16];
  #pragma unroll
  for(int r=0;r<16;++r)rli[r]=__builtin_amdgcn_rcpf(wsf[32+crow(r,hi)]);
  bf16*Ow=O+(rowbase+q0+wid*QBLK)*DM+h*D;
  { bf16*stg=(bf16*)(shm+LDS_OST)+wid*2048;
    #pragma unroll
    for(int r=0;r<16;++r){const int orow=crow(r,hi);
      #pragma unroll
      for(int d0=0;d0<2;++d0)stg[orow*64+d0*32+r32]=__float2bfloat16(o[d0][r]*rli[r]);}
    asm volatile("s_waitcnt lgkmcnt(0)":::"memory");
    #pragma unroll
    for(int i=0;i<4;++i){const int row=i*8+(lane>>3),ch=lane&7; const u32x4 v=*(const u32x4*)(stg+row*64+ch*8); ATTN_STORE16(Ow+(long)row*DM+ch*8,v);} }
  asm volatile("s_waitcnt lgkmcnt(0)\n\ts_barrier":::"memory");
  #undef DMA_K
  #undef DMA_V
  #undef CMASK
  #undef START
  #undef RESC
  #undef ROT
  #undef CBINIT
  #undef CBLD
}
constexpr int ATTN_LDS_BYTES=LDS_BYTES;
struct AttnTensors { const bf16* Q; const bf16* K; const bf16* V; bf16* O; };
struct AttnUnit { int bh; int qb; };
template<int THRL=8> __device__ __forceinline__ void attn_queue(char*lds,const AttnTensors&T,const float*CB,unsigned*ctr,volatile __attribute__((address_space(3))) unsigned*slot){
  int t_=threadIdx.x; asm volatile("":"+v"(t_));
  const unsigned x0=((unsigned)__builtin_amdgcn_s_getreg((3<<11)|20))&7u;
  constexpr unsigned PERQ=(unsigned)(BATCH*NHEAD*NQB/8);
  for(unsigned j=0;j<8u;++j){ const unsigned x=(x0+j)&7u;
    if(t_==0)*slot=__hip_atomic_fetch_add(ctr+64*x,1u,__ATOMIC_RELAXED,__HIP_MEMORY_SCOPE_AGENT);
    __syncthreads();
    unsigned q=(unsigned)__builtin_amdgcn_readfirstlane((int)*slot);
    while(q<PERQ){
      unsigned nq=0u; if(t_==0)nq=__hip_atomic_fetch_add(ctr+64*x,1u,__ATOMIC_RELAXED,__HIP_MEMORY_SCOPE_AGENT);
      const int qb=NQB-1-(int)(q>>4),bh=(int)(x*16u+(q&15u));
      attn_unit<THRL>(bh/NHEAD,bh%NHEAD,qb,T.Q,T.K,T.V,T.O,lds,CB+(long)bh*SEQ);
      if(t_==0)*slot=nq;
      __syncthreads();
      q=(unsigned)__builtin_amdgcn_readfirstlane((int)*slot);
    }
    __syncthreads();
  }
}
#undef SBAR
#undef WAIT_BAR
}
#define GAS __attribute__((address_space(1)))
#define LAS __attribute__((address_space(3)))
typedef unsigned short bf16;
typedef unsigned v4u __attribute__((ext_vector_type(4)));
typedef float f32x4 __attribute__((ext_vector_type(4)));
typedef short bf16x8 __attribute__((ext_vector_type(8)));
typedef GAS unsigned gu32;
typedef GAS unsigned long long gu64;
#define RLX_AGENT __ATOMIC_RELAXED, __HIP_MEMORY_SCOPE_AGENT
#define LDS_WAIT() asm volatile("s_waitcnt lgkmcnt(0)" ::: "memory")
#define VM_WAIT() asm volatile("s_waitcnt vmcnt(0)" ::: "memory")
__device__ __forceinline__ unsigned long long rt() { return __builtin_amdgcn_s_memrealtime(); }
__device__ __forceinline__ unsigned f2bf(float f) { unsigned u = __builtin_bit_cast(unsigned, f); return (u + 0x7fffu + ((u >> 16) & 1u)) >> 16; }
__device__ __forceinline__ unsigned pk2(float lo, float hi) { return f2bf(lo) | (f2bf(hi) << 16); }
#define XB_TMO      128
#define XB_XCNT(j)  (256  + 64 * (j))
#define XB_XSUB(j)  (1280 + 64 * (j))
#define XB_XGEN(j)  (2304 + 64 * (j))
#define XB_TOP      3328
#define XB_TOPGEN   3392
#define XCD_BAR_WORDS 3456
#define XB_SPIN_CAP (1u << 18)

__device__ __forceinline__ unsigned xb_ld(unsigned* p)              { return __hip_atomic_load(p, __ATOMIC_RELAXED, __HIP_MEMORY_SCOPE_AGENT); }
__device__ __forceinline__ unsigned xb_add(unsigned* p, unsigned v) { return __hip_atomic_fetch_add(p, v, __ATOMIC_RELAXED, __HIP_MEMORY_SCOPE_AGENT); }
__device__ __forceinline__ unsigned xb_xcc_id() { return (unsigned)__builtin_amdgcn_s_getreg((3 << 11) | 20) & 0xFu; }
#define XB_SPIN(cond, bar) do { unsigned _sp = 0; while (cond) { __builtin_amdgcn_s_sleep(1); \
    if ((++_sp & 255u) == 0u) { if (xb_ld(&(bar)[XB_TMO])) break; if (_sp > XB_SPIN_CAP) { atomicAdd(&(bar)[XB_TMO], 1u); break; } } } } while (0)

struct XcdBarrier {
    unsigned* bar; unsigned x;
    volatile LAS unsigned* st;
};

__device__ __forceinline__ XcdBarrier xcd_barrier_post(unsigned* bar, volatile LAS unsigned* st) {
    XcdBarrier b; b.bar = bar; b.x = xb_xcc_id(); b.st = st;
    if (threadIdx.x == 0) (void)xb_add(&bar[XB_XCNT(b.x)], 1u);
    return b;
}
__device__ __forceinline__ void xcd_barrier_complete(unsigned* bar, unsigned x, unsigned& nloc, unsigned& nx) {
    const unsigned G = gridDim.x * gridDim.y * gridDim.z;
    unsigned sum, cnt, mine, sp = 0u;
    for (;;) {
        sum = 0u; cnt = 0u; mine = 0u;
#pragma unroll
        for (unsigned j = 0; j < 16; ++j) { const unsigned c = xb_ld(&bar[XB_XCNT(j)]); sum += c; cnt += (c > 0u) ? 1u : 0u; mine = (j == x) ? c : mine; }
        if (sum == G) break;
        __builtin_amdgcn_s_sleep(1);
        if ((++sp & 255u) == 0u) { if (xb_ld(&bar[XB_TMO])) break; if (sp > XB_SPIN_CAP) { atomicAdd(&bar[XB_TMO], 1u); break; } }
    }
    nloc = mine > 0u ? mine : 1u; nx = cnt > 0u ? cnt : 1u;
}

__device__ __forceinline__ void xcd_barrier(const XcdBarrier& b) {
    asm volatile("s_waitcnt vmcnt(0)" ::: "memory");
    __syncthreads();
    if (threadIdx.x == 0) {
        unsigned* bar = b.bar;
        __builtin_amdgcn_s_waitcnt(0);
        unsigned nloc = b.st[0], nx = b.st[1];
        if (nloc == 0u) { xcd_barrier_complete(bar, b.x, nloc, nx); b.st[0] = nloc; b.st[1] = nx; }
        const unsigned old = xb_add(&bar[XB_XSUB(b.x)], 1u);
        const unsigned gen = old / nloc;
        if (old + 1u == (gen + 1u) * nloc) {
            __builtin_amdgcn_fence(__ATOMIC_RELEASE, "agent");
            asm volatile("s_waitcnt vmcnt(0)" ::: "memory");
            const unsigned og = xb_add(&bar[XB_TOP], 1u);
            const unsigned tg = og / nx;
            if (og + 1u == (tg + 1u) * nx) xb_add(&bar[XB_TOPGEN], 1u);
            else XB_SPIN(xb_ld(&bar[XB_TOPGEN]) == tg, bar);
            __builtin_amdgcn_fence(__ATOMIC_ACQUIRE, "agent");
            xb_add(&bar[XB_XGEN(b.x)], 1u);
            asm volatile("s_waitcnt vmcnt(0)" ::: "memory");
        } else {
            XB_SPIN(xb_ld(&bar[XB_XGEN(b.x)]) == gen, bar);
            __builtin_amdgcn_fence(__ATOMIC_ACQUIRE, "agent");
            asm volatile("s_waitcnt vmcnt(0)" ::: "memory");
        }
    }
    __syncthreads();
}
constexpr int NWAVES = 8;
constexpr int DM = 1024, NB = 16, SEQ = 4096, DEPTH = 4, M = NB * SEQ;
constexpr int NMEM = 256, MROWS = NB * NMEM;
constexpr int DFF = 4096, INW = 5648;
constexpr float EPS = 1e-6f, LOG2E = 1.4426950408889634f;
constexpr float FOX_QS = 0.125f * LOG2E;
constexpr float X_QS = 0.0625f * LOG2E;
constexpr float ML_KS = 0.08838834764831845f;

constexpr size_t MiB = 1u << 20;
constexpr size_t WS_CTL = 0, CTL_ZERO_BYTES = 64 * 1024;
constexpr size_t WS_FFL = 1 * MiB;
constexpr size_t WS_IG = 3 * MiB;
constexpr size_t WS_LF = 4 * MiB;
constexpr size_t WS_CN2 = 5 * MiB;
constexpr size_t WS_MG = 8 * MiB;
constexpr size_t WS_W = 16 * MiB, WL = 36 * MiB;
constexpr size_t WT_IN = 0  , WT_GF = 8 * MiB, WT_GM = 10 * MiB, WT_UPF = 12 * MiB, WT_UPM = 13 * MiB, WT_MIX = 14 * MiB, WT_XQ = 16 * MiB, WT_XO = 18 * MiB,
                 WT_M1 = 20 * MiB, WT_M2 = 28 * MiB;
constexpr int NIN = 3584;
constexpr size_t WS_XK = 160 * MiB, XK_STRIDE = 8 * MiB + 2048;
constexpr size_t WS_XVT = 193 * MiB, XVT_STRIDE = 8 * MiB + 8192;
constexpr size_t WS_XN = 226 * MiB;
constexpr size_t WS_BIG = 354 * MiB, SLOT = 64 * MiB;
constexpr size_t WS_SSP = WS_BIG + 8 * SLOT;
constexpr size_t WS_CQK = WS_SSP + 4 * MiB;
constexpr size_t WS_END = WS_CQK + 128 * MiB;
constexpr int CW_TMO = 0, CW_CODE = 1, CW_BAR = 4096, CW_QUEUE = 8192;

constexpr int RING_OFF = 0, RING_BYTES = 131072;
constexpr int RSL_OFF = RING_BYTES, RSL_BYTES = 16384;
constexpr int RED_OFF = RSL_OFF + RSL_BYTES, RED_BYTES = 8192;
constexpr int LDS_BYTES = RED_OFF + RED_BYTES + 512;
constexpr int LDSCTL_OFF = LDS_BYTES - 512, MISC_OFF = LDSCTL_OFF + 320;
static_assert(WS_XK + 3 * XK_STRIDE + 8 * MiB <= WS_XVT && WS_XVT + 3 * XVT_STRIDE + 8 * MiB <= WS_XN && WS_XN + 128 * MiB <= WS_BIG && WS_MG + 64 * (5 * 4096 + 64) * 4 <= WS_W && WS_W + 4 * WL <= WS_XK && WS_END <= (size_t)1024 * MiB, "d_ws map");
struct Frame {
    LAS unsigned char* lds;
    volatile LAS unsigned* MISC;
    gu32* ctl;
    int tid, lane, wave;
    int vcu, G;
};
__device__ __forceinline__ float shx(float v, int o, int lane) { return __builtin_bit_cast(float, __builtin_amdgcn_ds_bpermute((lane ^ o) << 2, __builtin_bit_cast(int, v))); }
__device__ __forceinline__ float shup(float v, int o, int lane) { return __builtin_bit_cast(float, __builtin_amdgcn_ds_bpermute((lane - o) << 2, __builtin_bit_cast(int, v))); }
__device__ __forceinline__ float wave_sum(float v, int lane) {
#pragma unroll
    for (int o = 1; o < 64; o <<= 1) v += shx(v, o, lane);
    return v;
}
__device__ __forceinline__ float wave_max(float v, int lane) {
#pragma unroll
    for (int o = 1; o < 64; o <<= 1) v = fmaxf(v, shx(v, o, lane));
    return v;
}
__device__ __forceinline__ float bf2f(unsigned short b) { return __uint_as_float((unsigned)b << 16); }
__device__ __forceinline__ float logsigmoid(float x) { return fminf(x, 0.f) - log1pf(expf(-fabsf(x))); }
__device__ __forceinline__ void unpack8(const v4u w, float* f) {
    f[0] = __uint_as_float(w.x << 16); f[1] = __uint_as_float(w.x & 0xffff0000u); f[2] = __uint_as_float(w.y << 16); f[3] = __uint_as_float(w.y & 0xffff0000u);
    f[4] = __uint_as_float(w.z << 16); f[5] = __uint_as_float(w.z & 0xffff0000u); f[6] = __uint_as_float(w.w << 16); f[7] = __uint_as_float(w.w & 0xffff0000u);
}

__device__ __forceinline__ void transpose_item(const float* W, int ld, int c0, int ncols, int K, bf16* WT, float scale, LAS float* scr, int item, int lane, const float* gain = nullptr) {
    const int nblk = ncols / 64, kb = item / nblk, nb = item % nblk, k0 = 64 * kb, n0 = 64 * nb;
    const int n4 = (lane & 15) * 4;
#pragma unroll 4
    for (int i = 0; i < 16; ++i) { const int kk = 4 * i + (lane >> 4); const float sc = gain ? scale * gain[k0 + kk] : scale;
        const f32x4 v = *(const GAS f32x4*)(W + (size_t)(k0 + kk) * ld + c0 + n0 + n4);
        LAS float* d = scr + kk * 65 + n4; d[0] = v.x * sc; d[1] = v.y * sc; d[2] = v.z * sc; d[3] = v.w * sc; }
    LDS_WAIT(); asm volatile("" ::: "memory");
    const int c = lane & 7;
#pragma unroll
    for (int j = 0; j < 8; ++j) { const int n = (lane >> 3) + 8 * j; const LAS float* s = scr + (8 * c) * 65 + n;
        v4u o; o.x = pk2(s[0 * 65], s[1 * 65]); o.y = pk2(s[2 * 65], s[3 * 65]); o.z = pk2(s[4 * 65], s[5 * 65]); o.w = pk2(s[6 * 65], s[7 * 65]);
        *(GAS v4u*)(WT + (size_t)(n0 + n) * K + k0 + 8 * c) = o; }
    LDS_WAIT(); asm volatile("" ::: "memory");
}
__device__ __forceinline__ void copy_item(const float* W, bf16* Wc, float scale, int item, int lane, const float* gain) {
    const int kb = item >> 4, nb = item & 15, k0 = 64 * kb, n0 = 64 * nb, n4 = (lane & 15) * 4;
#pragma unroll 4
    for (int i = 0; i < 16; ++i) { const int kk = 4 * i + (lane >> 4); const float sc = scale * gain[k0 + kk];
        const f32x4 v = *(const GAS f32x4*)(W + (size_t)(k0 + kk) * DM + n0 + n4);
        *(GAS unsigned long long*)(Wc + (size_t)(k0 + kk) * DM + n0 + n4) = (unsigned long long)pk2(v.x * sc, v.y * sc) | ((unsigned long long)pk2(v.z * sc, v.w * sc) << 32); }
}
constexpr int ITEMS_PER_LAYER = 128 + 256 + 512 + 256 + 256 + 128 + 128 + 256 + 256 + 256 + 256 + 256 + 1024 + 1024;
#define KAS __attribute__((address_space(4)))
__device__ __forceinline__ void p0_prologue(Frame& F, const KAS char* ka, unsigned char* ws) {
#define PIN(k) (*(const float* const KAS*)(ka + 8 * (k)))
    LAS float* scr = (LAS float*)(F.lds + RING_OFF + F.wave * 16640);
    const int gw = F.vcu * NWAVES + F.wave, NGW = F.G * NWAVES;
    for (int it = gw; it < DEPTH * ITEMS_PER_LAYER; it += NGW) {
        const int l = it / ITEMS_PER_LAYER; int r = it % ITEMS_PER_LAYER;
        unsigned char* wl = ws + WS_W + (size_t)l * WL;
        const float* w_in = PIN(6) + (size_t)l * DM * INW;
        bf16* wtin = (bf16*)(wl + WT_IN);
        if (r < 128) { transpose_item(w_in, INW, 0, 512, DM, wtin, FOX_QS, scr, r, F.lane, PIN(2) + (size_t)l * DM); continue; } r -= 128;
        if (r < 256) { transpose_item(w_in, INW, 512, 1024, DM, wtin + (size_t)512 * DM, 1.f, scr, r, F.lane, PIN(2) + (size_t)l * DM); continue; } r -= 256;
        if (r < 512) { transpose_item(w_in, INW, 1544, 2048, DM, wtin + (size_t)1536 * DM, 1.f, scr, r, F.lane, PIN(2) + (size_t)l * DM); continue; } r -= 512;
        if (r < 256) { transpose_item(w_in, INW, 3600, 1024, DM, (bf16*)(wl + WT_GF), 1.f, scr, r, F.lane, PIN(2) + (size_t)l * DM); continue; } r -= 256;
        if (r < 256) { transpose_item(w_in, INW, 4624, 1024, DM, (bf16*)(wl + WT_GM), 1.f, scr, r, F.lane, PIN(2) + (size_t)l * DM); continue; } r -= 256;
        if (r < 128) { transpose_item(PIN(14) + (size_t)l * 512 * DM, DM, 0, DM, 512, (bf16*)(wl + WT_UPF), 1.f, scr, r, F.lane); continue; } r -= 128;
        if (r < 128) { transpose_item(PIN(15) + (size_t)l * 512 * DM, DM, 0, DM, 512, (bf16*)(wl + WT_UPM), 1.f, scr, r, F.lane); continue; } r -= 128;
        if (r < 256) { transpose_item(PIN(16) + (size_t)l * DM * DM, DM, 0, DM, DM, (bf16*)(wl + WT_MIX), 1.f, scr, r, F.lane); continue; } r -= 256;
        if (r < 256) { copy_item(PIN(17) + (size_t)l * DM * DM, (bf16*)(wl + WT_XQ), X_QS, r, F.lane, PIN(3) + (size_t)l * DM); continue; } r -= 256;
        if (r < 256) { transpose_item(PIN(18) + (size_t)l * DM * 2 * DM, 2 * DM, 0, DM, DM, (bf16*)(ws + WS_BIG + (size_t)l * 2 * MiB), 1.f, scr, r, F.lane); continue; } r -= 256;
        if (r < 256) { transpose_item(PIN(18) + (size_t)l * DM * 2 * DM, 2 * DM, DM, DM, DM, (bf16*)(ws + WS_BIG + 8 * MiB + (size_t)l * 2 * MiB), 1.f, scr, r, F.lane); continue; } r -= 256;
        if (r < 256) { transpose_item(PIN(19) + (size_t)l * DM * DM, DM, 0, DM, DM, (bf16*)(wl + WT_XO), 1.f, scr, r, F.lane); continue; } r -= 256;
        if (r < 1024) { transpose_item(PIN(20) + (size_t)l * DM * DFF, DFF, 0, DFF, DM, (bf16*)(wl + WT_M1), 1.f, scr, r, F.lane, PIN(5) + (size_t)l * DM); continue; } r -= 1024;
        transpose_item(PIN(21) + (size_t)l * DFF * DM, DM, 0, DM, DFF, (bf16*)(wl + WT_M2), 1.f, scr, r, F.lane);
    }
    for (int idx = (F.vcu * NWAVES + F.wave) * 64 + F.lane; idx < DEPTH * 256 * DM; idx += F.G * NWAVES * 64) {
        const int l = idx >> 18, c = (idx >> 10) & 255, k = idx & 1023;
        float v = 0.f;
        if (c < 16) { const int col = c < 8 ? 1536 + c : (c < 12 ? 3592 + (c - 8) : 3596 + (c - 12)); v = PIN(6)[(size_t)l * DM * INW + (size_t)k * INW + col] * PIN(2)[(size_t)l * DM + k]; }
        ((bf16*)(ws + WS_W + (size_t)l * WL + WT_IN))[(size_t)(3584 + c) * DM + k] = (bf16)f2bf(v);
    }
    for (int m = gw; m < MROWS; m += NGW) {
        const GAS f32x4* xr = (const GAS f32x4*)(PIN(1) + (size_t)m * DM) + F.lane;
        f32x4 v[4]; float s2 = 0.f;
#pragma unroll
        for (int j = 0; j < 4; ++j) { v[j] = xr[64 * j]; s2 += (v[j].x * v[j].x + v[j].y * v[j].y) + (v[j].z * v[j].z + v[j].w * v[j].w); }
        const float r = 1.f / sqrtf(wave_sum(s2, F.lane) * (1.f / DM) + EPS);
#pragma unroll
        for (int l = 0; l < DEPTH; ++l) {
            GAS unsigned long long* o8 = (GAS unsigned long long*)(ws + WS_BIG + 16 * MiB + (size_t)l * 8 * MiB + (size_t)m * DM * 2) + F.lane;
#pragma unroll
            for (int j = 0; j < 4; ++j) { const f32x4 g = ((const GAS f32x4*)(PIN(4) + (size_t)l * DM))[F.lane + 64 * j];
                o8[64 * j] = (unsigned long long)pk2(v[j].x * r * g.x, v[j].y * r * g.y) | ((unsigned long long)pk2(v[j].z * r * g.z, v[j].w * r * g.w) << 32); }
        }
    }
}

__device__ __forceinline__ void x0_phase(Frame& F, const float* x, bf16* XN, float* SSP) {
    const int gw = F.vcu * NWAVES + F.wave, NGW = F.G * NWAVES;
    for (int m = gw; m < M; m += NGW) {
        const GAS f32x4* xr = (const GAS f32x4*)(x + (size_t)m * DM) + F.lane;
        f32x4 v[4]; float s2 = 0.f;
#pragma unroll
        for (int j = 0; j < 4; ++j) { v[j] = xr[64 * j]; s2 += (v[j].x * v[j].x + v[j].y * v[j].y) + (v[j].z * v[j].z + v[j].w * v[j].w); }
        s2 = wave_sum(s2, F.lane);
        GAS unsigned long long* o8 = (GAS unsigned long long*)(XN + (size_t)m * DM) + F.lane;
#pragma unroll
        for (int j = 0; j < 4; ++j) o8[64 * j] = (unsigned long long)pk2(v[j].x, v[j].y) | ((unsigned long long)pk2(v[j].z, v[j].w) << 32);
        if (F.lane < 16) SSP[(size_t)m * 16 + F.lane] = (F.lane == 0) ? s2 : 0.f;
    }
}
__device__ __forceinline__ void gates_phase(Frame& F, const bf16* XN, const float* SSP, const bf16* WGB, const float* bff, const float* bmi, const float* bmf, float* FFL, float* IG, float* LF) {
    typedef short bf16x8_t __attribute__((ext_vector_type(8)));
    for (int i = F.tid; i < 16 * 128; i += NWAVES * 64) *(LAS v4u*)(F.lds + RING_OFF + (i >> 7) * 2064 + (i & 127) * 16) = *(const GAS v4u*)(WGB + (size_t)(i >> 7) * DM + (i & 127) * 8);
    __syncthreads();
    const int gw = F.vcu * NWAVES + F.wave, NGW = F.G * NWAVES, i16 = F.lane & 15, g = F.lane >> 4;
    const LAS unsigned char* bl = F.lds + RING_OFF + i16 * 2064 + g * 16;
    const float bias = i16 < 8 ? bff[i16] : (i16 < 12 ? bmi[i16 - 8] : bmf[i16 - 12]);
    for (int grp = gw; grp < M / 32; grp += NGW) {
        const size_t row0 = (size_t)grp * 32;
        f32x4 acc[2] = {{0.f, 0.f, 0.f, 0.f}, {0.f, 0.f, 0.f, 0.f}};
        const bf16* ap = XN + (row0 + i16) * DM + 8 * g;
#pragma unroll 8
        for (int ks = 0; ks < 32; ++ks) { const bf16x8_t b = *(const LAS bf16x8_t*)(bl + 64 * ks);
            acc[0] = __builtin_amdgcn_mfma_f32_16x16x32_bf16(*(const GAS bf16x8_t*)(ap + 32 * ks), b, acc[0], 0, 0, 0);
            acc[1] = __builtin_amdgcn_mfma_f32_16x16x32_bf16(*(const GAS bf16x8_t*)(ap + 16 * DM + 32 * ks), b, acc[1], 0, 0, 0); }
#pragma unroll
        for (int h = 0; h < 2; ++h)
#pragma unroll
            for (int r = 0; r < 4; ++r) { const size_t row = row0 + 16 * h + 4 * g + r;
                const f32x4 p0 = *(const GAS f32x4*)(SSP + row * 16), p1 = *(const GAS f32x4*)(SSP + row * 16 + 4), p2 = *(const GAS f32x4*)(SSP + row * 16 + 8), p3 = *(const GAS f32x4*)(SSP + row * 16 + 12);
                const float ss = (((p0[0] + p0[1]) + (p0[2] + p0[3])) + ((p1[0] + p1[1]) + (p1[2] + p1[3]))) + (((p2[0] + p2[1]) + (p2[2] + p2[3])) + ((p3[0] + p3[1]) + (p3[2] + p3[3])));
                const float v = acc[h][r] * (1.f / sqrtf(ss * (1.f / DM) + EPS)) + bias;
                if (i16 < 8) FFL[row * 8 + i16] = logsigmoid(v);
                else if (i16 < 12) IG[row * 4 + (i16 - 8)] = v;
                else LF[row * 4 + (i16 - 12)] = logsigmoid(v); }
    }
    __syncthreads();
}

__device__ __forceinline__ void fox_scan(Frame& F, const float* FFL, float* CN2) {
    LAS float* wt = (LAS float*)(F.lds + RING_OFF);
    for (int seq = blockIdx.x; seq < NB * 8; seq += gridDim.x) {
        const int b = seq >> 3, hh = seq & 7;
        const float* src = FFL + (size_t)b * SEQ * 8 + hh;
        float x[8]; float run = 0.f;
#pragma unroll
        for (int k = 0; k < 8; ++k) { run += src[(size_t)(F.tid * 8 + k) * 8]; x[k] = run; }
        float incl = run;
#pragma unroll
        for (int o = 1; o < 64; o <<= 1) { const float t = shup(incl, o, F.lane); if (F.lane >= o) incl += t; }
        if (F.lane == 63) wt[F.wave] = incl;
        __syncthreads();
        float off = 0.f;
#pragma unroll
        for (int w = 0; w < NWAVES; ++w) if (w < F.wave) off += wt[w];
        const float excl = off + incl - run;
#pragma unroll
        for (int k = 0; k < 8; ++k) CN2[(size_t)seq * SEQ + F.tid * 8 + k] = -LOG2E * (excl + x[k]);
        __syncthreads();
    }
}

__device__ __forceinline__ void conv_phase(Frame& F, const bf16* MQK, bf16* CQK, const float* conv_w, const float* conv_b) {
    const int gw = F.vcu * NWAVES + F.wave, NGW = F.G * NWAVES;
    for (int task = gw; task < (M / 64) * 2; task += NGW) {
        const int tb = task >> 1, half = task & 1, gc = half * 512 + F.lane * 8;
        float cw[4][8], cb[8];
#pragma unroll
        for (int j = 0; j < 4; ++j) { const f32x4 a = *(const GAS f32x4*)(conv_w + j * 1024 + gc), bq = *(const GAS f32x4*)(conv_w + j * 1024 + gc + 4);
            cw[j][0] = a[0]; cw[j][1] = a[1]; cw[j][2] = a[2]; cw[j][3] = a[3]; cw[j][4] = bq[0]; cw[j][5] = bq[1]; cw[j][6] = bq[2]; cw[j][7] = bq[3]; }
        { const f32x4 a = *(const GAS f32x4*)(conv_b + gc), bq = *(const GAS f32x4*)(conv_b + gc + 4); cb[0] = a[0]; cb[1] = a[1]; cb[2] = a[2]; cb[3] = a[3]; cb[4] = bq[0]; cb[5] = bq[1]; cb[6] = bq[2]; cb[7] = bq[3]; }
        const float osc = half ? ML_KS : 1.f;
        const size_t row0 = (size_t)tb * 64; const bool first = (tb & 63) == 0;
        float x0[8], x1[8], x2[8];
        { v4u w0 = {0u, 0u, 0u, 0u}, w1 = w0, w2 = w0;
          if (!first) { w0 = *(const GAS v4u*)(MQK + (row0 - 3) * 1024 + gc); w1 = *(const GAS v4u*)(MQK + (row0 - 2) * 1024 + gc); w2 = *(const GAS v4u*)(MQK + (row0 - 1) * 1024 + gc); }
          unpack8(w0, x0); unpack8(w1, x1); unpack8(w2, x2); }
#pragma unroll 4
        for (int t = 0; t < 64; ++t) { float x3[8]; unpack8(*(const GAS v4u*)(MQK + (row0 + t) * 1024 + gc), x3); float y[8];
#pragma unroll
            for (int ch = 0; ch < 8; ++ch) { const float v = cb[ch] + cw[0][ch] * x0[ch] + cw[1][ch] * x1[ch] + cw[2][ch] * x2[ch] + cw[3][ch] * x3[ch];
                y[ch] = osc * v * __builtin_amdgcn_rcpf(1.f + __expf(-v)); x0[ch] = x1[ch]; x1[ch] = x2[ch]; x2[ch] = x3[ch]; }
            v4u o; o.x = pk2(y[0], y[1]); o.y = pk2(y[2], y[3]); o.z = pk2(y[4], y[5]); o.w = pk2(y[6], y[7]);
            *(GAS v4u*)(CQK + (row0 + t) * 1024 + gc) = o; }
    }
}

__device__ __forceinline__ void final_norm(Frame& F, const bf16* H, float* out, const float* gain) {
    const int gw = F.vcu * NWAVES + F.wave, NGW = F.G * NWAVES;
    f32x4 g4[4];
#pragma unroll
    for (int j = 0; j < 4; ++j) g4[j] = ((const GAS f32x4*)gain)[F.lane + 64 * j];
    for (int m = gw; m < M; m += NGW) {
        const GAS unsigned long long* hr = (const GAS unsigned long long*)(H + (size_t)m * DM) + F.lane;
        GAS f32x4* xr = (GAS f32x4*)(out + (size_t)m * DM) + F.lane;
        f32x4 v[4]; float s2 = 0.f;
#pragma unroll
        for (int j = 0; j < 4; ++j) { const unsigned long long w = hr[64 * j];
            v[j] = (f32x4){__uint_as_float((unsigned)w << 16), __uint_as_float((unsigned)w & 0xffff0000u), __uint_as_float((unsigned)(w >> 32) << 16), __uint_as_float((unsigned)(w >> 32) & 0xffff0000u)};
            s2 += (v[j].x * v[j].x + v[j].y * v[j].y) + (v[j].z * v[j].z + v[j].w * v[j].w); }
        const float r = 1.f / sqrtf(wave_sum(s2, F.lane) * (1.f / DM) + EPS);
#pragma unroll
        for (int j = 0; j < 4; ++j) xr[64 * j] = v[j] * r * g4[j];
    }
}
namespace ml {
typedef short bf16x8 __attribute__((ext_vector_type(8)));
typedef short s16x4 __attribute__((ext_vector_type(4)));
typedef float f32x4 __attribute__((ext_vector_type(4)));
typedef unsigned u32x4 __attribute__((ext_vector_type(4)));
typedef unsigned u32x2 __attribute__((ext_vector_type(2)));
constexpr int IMG = 64 * 272, QI = 0, KI = IMG, VI = 2 * IMG, VWI = 3 * IMG, PI = 4 * IMG, RSP = PI + 64 * 144, QNP = RSP + 1024, NRM = QNP + 2048, NV = NRM + 2048, NVP = NV + 512  , GSC = NVP + 2048  , BC = GSC + 1536, PM = BC + 16384, BLA = PM + 16384, MLA = BLA + 256, MPA = MLA + 256, MNA = MPA + 256, LDS_END = MNA + 256;
static_assert(LDS_END <= 131072, "mLSTM LDS map");
constexpr int MG_STRIDE = 5 * 4096 + 64;
__device__ __forceinline__ unsigned off_b(unsigned row, unsigned ch) { return 272u * row + 16u * ch; }
__device__ __forceinline__ unsigned cvtpk(float lo, float hi) { typedef float f2 __attribute__((ext_vector_type(2))); typedef __bf16 b2 __attribute__((ext_vector_type(2))); f2 v = {lo, hi}; b2 b = __builtin_convertvector(v, b2); return __builtin_bit_cast(unsigned, b); }
__device__ __forceinline__ float blo(unsigned w) { return __uint_as_float(w << 16); }
__device__ __forceinline__ float bhi(unsigned w) { return __uint_as_float(w & 0xffff0000u); }
#define ML_LDS(T, off) ((__attribute__((address_space(3))) T*)(lds + (off)))
__device__ __forceinline__ bf16x8 rd128(LAS unsigned char* lds, unsigned off) { return *(const __attribute__((address_space(3))) bf16x8*)(lds + off); }
__device__ __forceinline__ s16x4 rdtr(LAS unsigned char* lds, unsigned off) { typedef short v4i16_t __attribute__((ext_vector_type(4))); return __builtin_bit_cast(s16x4, __builtin_amdgcn_ds_read_tr16_b64_v4i16((__attribute__((address_space(3))) v4i16_t*)(lds + off))); }
__device__ __forceinline__ s16x4 rd64(LAS unsigned char* lds, unsigned off) { return *(const __attribute__((address_space(3))) s16x4*)(lds + off); }
__device__ __forceinline__ bf16x8 cat(s16x4 a, s16x4 b) { return (bf16x8){a[0], a[1], a[2], a[3], b[0], b[1], b[2], b[3]}; }
#define ML_MFMA(a, b, c) __builtin_amdgcn_mfma_f32_16x16x32_bf16(a, b, c, 0, 0, 0)
#define ML_BAR() do { asm volatile("s_waitcnt lgkmcnt(0)" ::: "memory"); __builtin_amdgcn_s_barrier(); asm volatile("" ::: "memory"); } while (0)

__device__ __forceinline__ void mlstm_unit(LAS unsigned char* lds, int tid_in, int b, int hh, const bf16* CQK, const bf16* MV, bf16* MO, const float* IG, const float* LF, const float* mnorm, float* MG) {
    const size_t tokb = (size_t)b * SEQ;
    int tid0 = tid_in; asm volatile("" : "+v"(tid0));
#define ML_IDX(T) const int tid = (T), lane = tid & 63, w = __builtin_amdgcn_readfirstlane(tid >> 6), i16 = lane & 15, g = lane >> 4; (void)i16; (void)g; (void)w; (void)lane
    float* U2 = MG; float* W2 = MG + 4096; float* IWA = MG + 8192; float* EMT = MG + 12288; float* WKA = MG + 16384; float* SOLD = MG + 20480;
    {   ML_IDX(tid0);
        for (int c = w; c < 64; c += 8) {
            const float ig = IG[(tokb + c * 64 + lane) * 4 + hh], lf = LF[(tokb + c * 64 + lane) * 4 + hh];
            float bc = lf;
#pragma unroll
            for (int o = 1; o < 64; o <<= 1) { const float t = shup(bc, o, lane); if (lane >= o) bc += t; }
            const float bL = __builtin_bit_cast(float, __builtin_amdgcn_readlane(__builtin_bit_cast(int, bc), 63));
            const float a = bL - bc + ig, mloc = wave_max(a, lane);
            float pm = ig - bc;
#pragma unroll
            for (int o = 1; o < 64; o <<= 1) { const float t = shup(pm, o, lane); if (lane >= o) pm = fmaxf(pm, t); }
            ML_LDS(float, BC)[c * 64 + lane] = bc; ML_LDS(float, PM)[c * 64 + lane] = pm;
            if (lane == 0) { ML_LDS(float, BLA)[c] = bL; ML_LDS(float, MLA)[c] = mloc; }
        }
        __syncthreads();
        if (tid == 0) { float m = 0.f;
            for (int c = 0; c < 64; ++c) { const float bL = ML_LDS(float, BLA)[c], mn = fmaxf(bL + m, ML_LDS(float, MLA)[c]);
                ML_LDS(float, MPA)[c] = m; ML_LDS(float, MNA)[c] = mn; SOLD[c] = expf(bL + m - mn); m = mn; } }
        __syncthreads();
#pragma unroll 1
        for (int k = 0; k < 8; ++k) { const int t = tid + 512 * k, c = t >> 6;
            const float ig = IG[(tokb + t) * 4 + hh], bc = ML_LDS(float, BC)[t], pm = ML_LDS(float, PM)[t], bL = ML_LDS(float, BLA)[c], mp = ML_LDS(float, MPA)[c], mn = ML_LDS(float, MNA)[c];
            const float il = bc + mp, mt = fmaxf(il, bc + pm);
            U2[t] = (bc - mt) * LOG2E; W2[t] = (ig - bc) * LOG2E; IWA[t] = expf(il - mt); EMT[t] = expf(-mt); WKA[t] = expf(bL - bc + ig - mn); }
        if (tid < 128) ML_LDS(float, NV)[tid] = 0.f;
        asm volatile("s_waitcnt vmcnt(0)" ::: "memory");
        __syncthreads();
    }
    float mng0, mng1, mng2, mng3;
    {   int tid1 = tid_in; asm volatile("" : "+v"(tid1)); ML_IDX(tid1);
        mng0 = mnorm[hh * 128 + 16 * w + 4 * g]; mng1 = mnorm[hh * 128 + 16 * w + 4 * g + 1]; mng2 = mnorm[hh * 128 + 16 * w + 4 * g + 2]; mng3 = mnorm[hh * 128 + 16 * w + 4 * g + 3];
    }
    f32x4 Ct[8];
#pragma unroll
    for (int t = 0; t < 8; ++t) Ct[t] = (f32x4){0.f, 0.f, 0.f, 0.f};
    float nreg = 0.f;
    u32x4 raw[4], vpre[2]; float wkpre[2]; float gpre[5]; float sopre;
#define ML_PREFETCH(cc) do { \
        _Pragma("unroll") for (int k_ = 0; k_ < 4; ++k_) raw[k_] = *(const GAS u32x4*)(CQK + (tokb + (cc) * 64 + 4 * tg + k_) * 1024 + gc); \
        _Pragma("unroll") for (int k_ = 0; k_ < 2; ++k_) { vpre[k_] = *(const GAS u32x4*)(MV + (tokb + (cc) * 64 + vrow0 + 32 * k_) * 512 + hh * 128 + vch * 8); wkpre[k_] = WKA[(cc) * 64 + vrow0 + 32 * k_]; } \
        if (tid < 64) { _Pragma("unroll") for (int a_ = 0; a_ < 5; ++a_) gpre[a_] = MG[a_ * 4096 + (cc) * 64 + tid]; sopre = SOLD[(cc)]; } } while (0)
#define ML_JOB const int kind = tid >> 8, ch8 = (tid >> 4) & 15, tg = tid & 15, gc = kind * 512 + hh * 128 + ch8 * 8, vrow0 = tid >> 4, vch = tid & 15, st = w >> 1, lt0 = 2 * (w & 1); (void)kind; (void)ch8; (void)st; (void)lt0
    { int tid2 = tid_in; asm volatile("" : "+v"(tid2)); ML_IDX(tid2); ML_JOB; ML_PREFETCH(0); }
#pragma unroll 1
    for (int c = 0; c < 64; ++c) {
        int tid_c = tid_in; asm volatile("" : "+v"(tid_c)); ML_IDX(tid_c); ML_JOB;
        const size_t tok0 = tokb + c * 64;
        u32x2 moc[4];
#pragma unroll
        for (int lt = 0; lt < 4; ++lt) moc[lt] = *(const GAS u32x2*)(MO + (tok0 + 16 * lt + i16) * 512 + hh * 128 + 16 * w + 4 * g);
        {
#pragma unroll
            for (int i = 0; i < 4; ++i) *ML_LDS(u32x4, (kind ? KI : QI) + off_b(4 * tg + i, ch8)) = raw[i];
#pragma unroll
            for (int k = 0; k < 2; ++k) { const int row = vrow0 + 32 * k; const u32x4 v = vpre[k]; const float s = wkpre[k];
                *ML_LDS(u32x4, VI + off_b(row, vch)) = v;
                const u32x4 o = {cvtpk(blo(v.x) * s, bhi(v.x) * s), cvtpk(blo(v.y) * s, bhi(v.y) * s), cvtpk(blo(v.z) * s, bhi(v.z) * s), cvtpk(blo(v.w) * s, bhi(v.w) * s)};
                *ML_LDS(u32x4, VWI + off_b(row, vch)) = o; }
        }
        if (tid < 64) {
#pragma unroll
            for (int a = 0; a < 5; ++a) ML_LDS(float, GSC)[a * 64 + tid] = gpre[a];
            if (tid == 0) ML_LDS(float, GSC)[320] = sopre; }
        if (c + 1 < 64) ML_PREFETCH(c + 1);
        ML_BAR();
        const float u2a = ML_LDS(float, GSC)[16 * lt0 + i16], u2b = ML_LDS(float, GSC)[16 * (lt0 + 1) + i16];
        const f32x4 w2v = *ML_LDS(f32x4, GSC + (64 + 16 * st + 4 * g) * 4);
        float iwv[4], emv[4];
#pragma unroll
        for (int lt = 0; lt < 4; ++lt) { iwv[lt] = ML_LDS(float, GSC)[128 + 16 * lt + i16]; emv[lt] = ML_LDS(float, GSC)[192 + 16 * lt + i16]; }
        const float s_old = ML_LDS(float, GSC)[320];
        {
            f32x4 s0 = {0.f, 0.f, 0.f, 0.f}, s1 = {0.f, 0.f, 0.f, 0.f};
#pragma unroll
            for (int ks = 0; ks < 4; ++ks) { const bf16x8 ka = rd128(lds, KI + off_b(i16 + 16 * st, 4 * ks + g));
                s0 = ML_MFMA(ka, rd128(lds, QI + off_b(i16 + 16 * lt0, 4 * ks + g)), s0); s1 = ML_MFMA(ka, rd128(lds, QI + off_b(i16 + 16 * (lt0 + 1), 4 * ks + g)), s1); }
#pragma unroll
            for (int q = 0; q < 2; ++q) { const int lt = lt0 + q; const f32x4 sv = q ? s1 : s0; const float u2 = q ? u2b : u2a; const int l = 16 * lt + i16; float p[4]; float ps = 0.f;
#pragma unroll
                for (int r = 0; r < 4; ++r) { const int s = 16 * st + 4 * g + r; const float v = sv[r] * __builtin_amdgcn_exp2f(u2 + w2v[r]); p[r] = (s <= l) ? v : 0.f; ps += p[r]; }
                ps = pg8::fq_sum(ps);
                if (g == 0) ML_LDS(float, RSP)[st * 64 + l] = ps;
                const u32x2 o = {cvtpk(p[0], p[1]), cvtpk(p[2], p[3])};
                *ML_LDS(u32x2, PI + 144 * l + 32 * st + 8 * g) = o; }
            { const int l = tid & 63, dp = tid >> 6; float acc = 0.f;
#pragma unroll
              for (int h2 = 0; h2 < 2; ++h2) { const u32x4 qv = *ML_LDS(u32x4, QI + off_b(l, 2 * dp + h2)); const f32x4 n0 = *ML_LDS(f32x4, NV + (16 * dp + 8 * h2) * 4), n1 = *ML_LDS(f32x4, NV + (16 * dp + 8 * h2 + 4) * 4);
                  acc += (blo(qv.x) * n0[0] + bhi(qv.x) * n0[1]) + (blo(qv.y) * n0[2] + bhi(qv.y) * n0[3]) + (blo(qv.z) * n1[0] + bhi(qv.z) * n1[1]) + (blo(qv.w) * n1[2] + bhi(qv.w) * n1[3]); }
              ML_LDS(float, QNP)[dp * 64 + l] = acc; }
        }
        ML_BAR();
        f32x4 H[4];
        {
            float inv[4];
#pragma unroll
            for (int lt = 0; lt < 4; ++lt) { const int l = 16 * lt + i16; float rs = 0.f, qn = 0.f;
#pragma unroll
                for (int k = 0; k < 4; ++k) rs += ML_LDS(float, RSP)[k * 64 + l];
#pragma unroll
                for (int k = 0; k < 8; ++k) qn += ML_LDS(float, QNP)[k * 64 + l];
                const float den = iwv[lt] * qn + rs; inv[lt] = __builtin_amdgcn_rcpf(fmaxf(fabsf(den), emv[lt])); }
            f32x4 hi_[4], hx_[4];
#pragma unroll
            for (int lt = 0; lt < 4; ++lt) { hi_[lt] = (f32x4){0.f, 0.f, 0.f, 0.f}; hx_[lt] = (f32x4){0.f, 0.f, 0.f, 0.f}; }
#define ML_SB() __builtin_amdgcn_sched_barrier(0)
#define ML_QB(kk_, lt_) cat(rd64(lds, QI + off_b(i16 + 16 * (lt_), 4 * (kk_) + (g >> 1)) + 8 * (g & 1)), rd64(lds, QI + off_b(i16 + 16 * (lt_), 4 * (kk_) + 2 + (g >> 1)) + 8 * (g & 1)))
            { bf16x8 qa[4][4];
#pragma unroll
              for (int kk = 0; kk < 4; ++kk)
#pragma unroll
                  for (int lt = 0; lt < 4; ++lt) qa[kk][lt] = ML_QB(kk, lt);
              ML_SB();
#pragma unroll
              for (int kk = 0; kk < 4; ++kk) { const u32x4 ca = {cvtpk(Ct[2 * kk][0], Ct[2 * kk][1]), cvtpk(Ct[2 * kk][2], Ct[2 * kk][3]), cvtpk(Ct[2 * kk + 1][0], Ct[2 * kk + 1][1]), cvtpk(Ct[2 * kk + 1][2], Ct[2 * kk + 1][3])};
#pragma unroll
                  for (int lt = 0; lt < 4; ++lt) hi_[lt] = ML_MFMA(__builtin_bit_cast(bf16x8, ca), qa[kk][lt], hi_[lt]); } }
            const unsigned trq = (lane & 15) >> 2, trp = lane & 3;
#pragma unroll
            for (int ks = 0; ks < 2; ++ks) { const bf16x8 va = cat(rdtr(lds, VI + off_b(32 * ks + 8 * g + trq, 2 * w + (trp >> 1)) + 8 * (trp & 1)), rdtr(lds, VI + off_b(32 * ks + 8 * g + 4 + trq, 2 * w + (trp >> 1)) + 8 * (trp & 1)));
#pragma unroll
                for (int lt = 0; lt < 4; ++lt) { const unsigned l = i16 + 16 * lt; hx_[lt] = ML_MFMA(va, rd128(lds, PI + 144 * l + 64 * ks + 16 * g), hx_[lt]); } }
#pragma unroll
            for (int lt = 0; lt < 4; ++lt) { H[lt] = (hi_[lt] * iwv[lt] + hx_[lt]) * inv[lt];
                float ss = (H[lt][0] * H[lt][0] + H[lt][1] * H[lt][1]) + (H[lt][2] * H[lt][2] + H[lt][3] * H[lt][3]);
                ss = pg8::fq_sum(ss);
                if (g == 0) ML_LDS(float, NRM)[w * 64 + 16 * lt + i16] = ss; }
#pragma unroll
            for (int t = 0; t < 8; ++t) Ct[t] = Ct[t] * s_old;
#define ML_KA(ks_, t_) cat(rdtr(lds, KI + off_b(32 * (ks_) + 8 * g + trq, 2 * (t_) + (trp >> 1)) + 8 * (trp & 1)), rdtr(lds, KI + off_b(32 * (ks_) + 8 * g + 4 + trq, 2 * (t_) + (trp >> 1)) + 8 * (trp & 1)))
#define ML_VB(ks_) cat(rdtr(lds, VWI + off_b(32 * (ks_) + 8 * g + trq, 2 * w + (trp >> 1)) + 8 * (trp & 1)), rdtr(lds, VWI + off_b(32 * (ks_) + 8 * g + 4 + trq, 2 * w + (trp >> 1)) + 8 * (trp & 1)))
            { bf16x8 ka[4], kn[4]; const bf16x8 vb0 = ML_VB(0), vb1 = ML_VB(1);
#pragma unroll
              for (int t = 0; t < 4; ++t) ka[t] = ML_KA(0, t);
              ML_SB();
#pragma unroll
              for (int grp = 0; grp < 4; ++grp) { const int ks = grp >> 1, tb = 4 * (grp & 1);
                  if (grp < 3) { const int ks2 = (grp + 1) >> 1, tb2 = 4 * ((grp + 1) & 1);
#pragma unroll
                      for (int t = 0; t < 4; ++t) kn[t] = ML_KA(ks2, tb2 + t); }
                  ML_SB();
#pragma unroll
                  for (int t = 0; t < 4; ++t) Ct[tb + t] = ML_MFMA(ka[t], ks ? vb1 : vb0, Ct[tb + t]);
                  ML_SB();
#pragma unroll
                  for (int t = 0; t < 4; ++t) ka[t] = kn[t]; } }
            { const int d = tid & 127, sq = tid >> 7; float acc = 0.f;
#pragma unroll
                for (int s = 0; s < 16; ++s) acc += ML_LDS(float, GSC)[256 + 16 * sq + s] * bf2f(*ML_LDS(unsigned short, KI + off_b(16 * sq + s, d >> 3) + 2 * (d & 7)));
                ML_LDS(float, NVP)[sq * 128 + d] = acc; }
        }
        ML_BAR();
        if (tid < 128) { nreg = s_old * nreg + ((ML_LDS(float, NVP)[tid] + ML_LDS(float, NVP)[128 + tid]) + (ML_LDS(float, NVP)[256 + tid] + ML_LDS(float, NVP)[384 + tid])); ML_LDS(float, NV)[tid] = nreg; }
#pragma unroll
        for (int lt = 0; lt < 4; ++lt) { const int l = 16 * lt + i16; float ss = 0.f;
#pragma unroll
            for (int k = 0; k < 8; ++k) ss += ML_LDS(float, NRM)[k * 64 + l];
            const float rs = __builtin_amdgcn_rsqf(ss * (1.f / 128.f) + EPS);
            const float m0 = blo(moc[lt].x), m1 = bhi(moc[lt].x), m2 = blo(moc[lt].y), m3 = bhi(moc[lt].y);
            const float y0 = H[lt][0] * rs * mng0 * m0, y1 = H[lt][1] * rs * mng1 * m1, y2 = H[lt][2] * rs * mng2 * m2, y3 = H[lt][3] * rs * mng3 * m3;
            *(GAS u32x2*)(MO + (tok0 + l) * 512 + hh * 128 + 16 * w + 4 * g) = (u32x2){cvtpk(y0, y1), cvtpk(y2, y3)}; }
    }
#undef ML_PREFETCH
#undef ML_SB
#undef ML_QB
#undef ML_KA
#undef ML_VB
#undef ML_IDX
#undef ML_JOB
}
#undef ML_LDS
#undef ML_MFMA
#undef ML_BAR
}
#ifndef MK_PER_PHASE
#define MK_PER_PHASE 0
#endif
#ifndef LAYERS_TEST
#define LAYERS_TEST DEPTH
#endif
#ifndef SITE_MASK
#define SITE_MASK 0xffffffffu
#endif
#define SITE_ON(k) ((SITE_MASK >> (k)) & 1u)
constexpr int PH_PER_LAYER = 16, NPH = 2 + DEPTH * PH_PER_LAYER + 1;
struct Args { const float* in[23]; float* out; unsigned char* ws; int ph_lo, ph_hi; };
__global__ void __launch_bounds__(NWAVES * 64, 2) trunk_fwd(Args args) {
    extern __shared__ __attribute__((aligned(16))) unsigned char lds[];
#if defined(PROBE_MASK)
    const unsigned long long pk0_ = __builtin_amdgcn_s_memrealtime();
#endif
    Frame F;
    F.lds = (LAS unsigned char*)lds;
    F.MISC = (volatile LAS unsigned*)(F.lds + MISC_OFF);
    F.tid = threadIdx.x; F.lane = F.tid & 63; F.wave = __builtin_amdgcn_readfirstlane(F.tid >> 6);
    F.G = gridDim.x; { const int bx = blockIdx.x; F.vcu = (F.G % 8 == 0) ? (bx % 8) * (F.G / 8) + bx / 8 : bx; }
    F.ctl = (gu32*)(args.ws + WS_CTL);
    for (int u = F.tid; u < (LDS_BYTES - LDSCTL_OFF) / 4; u += NWAVES * 64) ((LAS unsigned*)(F.lds + LDSCTL_OFF))[u] = 0u;
    __syncthreads();
    XcdBarrier bar; bar.bar = (unsigned*)(F.ctl + CW_BAR); bar.x = 0; bar.st = nullptr;
    if (!MK_PER_PHASE) bar = xcd_barrier_post((unsigned*)(F.ctl + CW_BAR), F.MISC + 8);
    const int lo = args.ph_lo, hi = args.ph_hi;
#define IN(k) (lo <= (k) && (k) < hi)
#if defined(PROBE_MASK)
#ifndef PROBE_LAYER
#define PROBE_LAYER -1
#endif
#ifndef PROBE_OFS
#define PROBE_OFS 0
#endif
#define PROBE_SEL(k) (((((k) < 2) ? (PROBE_MASK >> 16) : ((k) == NPH - 1) ? (PROBE_MASK >> 17) : (PROBE_MASK >> (((k) - 2) % PH_PER_LAYER))) & 1u) && (PROBE_LAYER < 0 || ((k) - 2) / PH_PER_LAYER == PROBE_LAYER))
#define PROBE_T0() do { if (blockIdx.x == 0 && threadIdx.x == 0) { const unsigned long long t_ = __builtin_amdgcn_s_memrealtime(); F.MISC[18] = (unsigned)t_; F.MISC[19] = (unsigned)(t_ >> 32); } } while (0)
#define PROBE_ACC(k) do { if (PROBE_SEL(k) && blockIdx.x == 0 && threadIdx.x == 0) { const unsigned long long d_ = __builtin_amdgcn_s_memrealtime() - ((unsigned long long)F.MISC[18] | ((unsigned long long)F.MISC[19] << 32)); F.MISC[16] = F.MISC[16] + (unsigned)d_; } } while (0)
#else
#define PROBE_T0() do {} while (0)
#define PROBE_ACC(k) do {} while (0)
#endif
#define SEAM(k) do { if (!MK_PER_PHASE && IN((k) + 1)) xcd_barrier(bar); PROBE_ACC(k); } while (0)
#ifndef STAG2_ON
#define STAG2_ON 0
#endif
#ifndef STAG_ON
#define STAG_ON 0
#endif
#define STAGGER_N(ngrp, us) do { if (STAG2_ON) { const unsigned long long t0_ = __builtin_amdgcn_s_memrealtime(); const unsigned long long d_ = (unsigned long long)((gB >> 3) & ((ngrp) - 1)) * (unsigned long long)(us) * 100ull; while (__builtin_amdgcn_s_memrealtime() - t0_ < d_) __builtin_amdgcn_s_sleep(8); } } while (0)
#define STAGGER(us) do { if (STAG_ON && (gB & 1)) { const unsigned long long t0_ = __builtin_amdgcn_s_memrealtime(); while (__builtin_amdgcn_s_memrealtime() - t0_ < (unsigned long long)(us) * 100ull) __builtin_amdgcn_s_sleep(8); } } while (0)
#define SEAM0(k, cond) do { if (!MK_PER_PHASE && IN((k) + 1) && (cond)) xcd_barrier(bar); PROBE_ACC(k); } while (0)
    constexpr size_t SL = SLOT / 2;

#define SITE_CTX(lay) const KAS char* ka = (const KAS char*)__builtin_amdgcn_kernarg_segment_ptr(); asm volatile("" : "+s"(ka)); \
    int ll = (lay); asm volatile("" : "+s"(ll)); int gG = F.G, gB = (int)blockIdx.x; asm volatile("" : "+s"(gG), "+s"(gB)); Frame Fl = F; { int t_ = threadIdx.x; asm volatile("" : "+v"(t_)); Fl.tid = t_; Fl.lane = t_ & 63; int w_ = __builtin_amdgcn_readfirstlane(t_ >> 6), v_ = F.vcu; asm volatile("" : "+s"(w_), "+s"(v_)); Fl.wave = w_; Fl.vcu = v_; Fl.G = gG; } \
    unsigned char* ws = *(unsigned char* const KAS*)(ka + 192); float* out = *(float* const KAS*)(ka + 184); const float* x = INP(0); \
    unsigned char* wl = ws + WS_W + (size_t)ll * WL; const float* hin0 = (ll == 0) ? x : out; bf16* XN = (bf16*)(ws + WS_XN); bf16* BIG = (bf16*)(ws + WS_BIG); \
    float* FFL = (float*)(ws + WS_FFL); float* IG = (float*)(ws + WS_IG); float* LF = (float*)(ws + WS_LF); float* CN2 = (float*)(ws + WS_CN2); \
    (void)wl; (void)hin0; (void)gG; (void)gB; (void)XN; (void)BIG; (void)FFL; (void)IG; (void)LF; (void)CN2; (void)x; (void)out
#define INP(k) (*(const float* const KAS*)(ka + 8 * (k)))
    static_assert(sizeof(Args) == 208, "kernarg layout: in[23] at 0, out at 184, ws at 192, ph_lo at 200, ph_hi at 204");

    if (IN(0)) { SITE_CTX(0); PROBE_T0(); p0_prologue(Fl, ka, ws); x0_phase(Fl, x, XN, (float*)(ws + WS_SSP)); SEAM(0); }
    if (IN(1)) { SITE_CTX(0); PROBE_T0();
        const bf16* memn = (const bf16*)(ws + WS_BIG + 16 * MiB);
        const bf16* wxk = (const bf16*)(ws + WS_BIG); const bf16* wxv = (const bf16*)(ws + WS_BIG + 8 * MiB);
        { pg8::Gemm g{memn, wxk, DEPTH * MROWS, DEPTH * DM, DM}; pg8::DiagOrder S{gG, gB, true};
          pg8::EpiB<0> E{(bf16*)(ws + WS_XK), DM, nullptr, nullptr, nullptr, nullptr, nullptr};
#if SITE_ON(0)
          pg8::gemm_phase<pg8::EpiB<0>, pg8::DiagOrder, true, true>(F.lds + RING_OFF, g, S, E);
#endif
        }
        { pg8::Gemm g{memn, wxv, DEPTH * MROWS, DEPTH * DM, DM}; pg8::DiagOrder S{gG, gB, true};
          pg8::EpiB<0> E{(bf16*)(ws + WS_XVT), DM, nullptr, nullptr, nullptr, nullptr, nullptr};
#if SITE_ON(1)
          pg8::gemm_phase<pg8::EpiB<0>, pg8::DiagOrder, true, true>(F.lds + RING_OFF, g, S, E);
#endif
        }
        SEAM(1);
    }
    for (int l = 0; l < LAYERS_TEST; ++l) {
        const int pb = 2 + PH_PER_LAYER * l;
        if (IN(pb + 1)) { SITE_CTX(l); PROBE_T0();
            gates_phase(Fl, XN, (const float*)(ws + WS_SSP), (const bf16*)(wl + WT_IN) + (size_t)3584 * DM, INP(7) + ll * 8, INP(8) + ll * 4, INP(9) + ll * 4, FFL, IG, LF);
            pg8::Gemm g{XN, (const bf16*)(wl + WT_IN), M, NIN, DM}; pg8::StaticOrder S; S.init(M, NIN, gG, gB);
            pg8::EpiIn E{(LAS float*)(F.lds + RSL_OFF), BIG, (const float*)(ws + WS_SSP), FFL, IG, LF, INP(7) + ll * 8, INP(8) + ll * 4, INP(9) + ll * 4};

#if SITE_ON(2)
pg8::gemm_phase<pg8::EpiIn, pg8::StaticOrder, true, true>(F.lds + RING_OFF, g, S, E);
#endif

            SEAM(pb + 1);
        }
        if (IN(pb + 2)) { SITE_CTX(l); PROBE_T0(); fox_scan(Fl, FFL, CN2); conv_phase(Fl, BIG + 3 * SL, (bf16*)(ws + WS_CQK), INP(11) + (size_t)ll * 4 * 1024, INP(12) + (size_t)ll * 1024); SEAM(pb + 2); }
        if (IN(pb + 3)) { SITE_CTX(l); PROBE_T0();
            { int mu = -1;
              if (gG == 256) { if (((gB >> 3) & 3) == 0) mu = (gB >> 5) * 8 + (gB & 7); }
              else if (gB < NB * 4) mu = gB;
#if defined(PROBE_NO_ML)
              mu = -1;
#endif
              for (; mu >= 0 && mu < NB * 4; mu += (gG == 256 ? NB * 4 : gG)) {
                  ml::mlstm_unit(Fl.lds + RING_OFF, Fl.tid, mu >> 2, mu & 3, (const bf16*)(ws + WS_CQK), BIG + 5 * SL, BIG + 6 * SL, IG, LF, INP(13) + (size_t)ll * 512,
                                 (float*)(ws + WS_MG) + (size_t)mu * ml::MG_STRIDE); __syncthreads(); } }
#if defined(PROBE_MASK)
            if (((PROBE_MASK >> 18) & 1u) && blockIdx.x == 0 && threadIdx.x == 0) { const unsigned long long d_ = __builtin_amdgcn_s_memrealtime() - ((unsigned long long)F.MISC[18] | ((unsigned long long)F.MISC[19] << 32)); F.MISC[16] = F.MISC[16] + (unsigned)d_; }
#endif
            { pg8::Gemm g{(const bf16*)(ws + WS_XK + (size_t)ll * XK_STRIDE), (const bf16*)(wl + WT_XQ), 2 * NB * DM, DM, 256, DM, DM};
              pg8::XPreOrder S{gG, gB, (const bf16*)(wl + WT_XO), (const bf16*)(ws + WS_XVT + (size_t)ll * XK_STRIDE)};
              pg8::EpiB<0> E{BIG + 7 * SL, DM, nullptr, nullptr, nullptr, nullptr, nullptr};
              pg8::gemm_phase<pg8::EpiB<0>, pg8::XPreOrder, true, true>(F.lds + RING_OFF, g, S, E); }
            { pg8::Gemm g{XN, (const bf16*)(wl + WT_GF), M, 2 * DM, DM}; pg8::SkewOrder S; S.init(M, gG, gB);
              pg8::EpiGate8 E{(unsigned char*)(BIG + 3 * SL), (unsigned char*)(BIG + 4 * SL), INP(10) + (size_t)ll * 2048, (const float*)(ws + WS_SSP), (LAS float*)(F.lds + RSL_OFF)};
#if SITE_ON(2)
              pg8::gemm_phase<pg8::EpiGate8, pg8::SkewOrder, true, true>(F.lds + RING_OFF, g, S, E);
#endif
            }
            { static_assert(attn_body::ATTN_LDS_BYTES <= RING_BYTES && attn_body::DM == 512, "attention body geometry vs frame");
              const attn_body::AttnTensors AT{(const attn_body::bf16*)BIG, (const attn_body::bf16*)(BIG + SL), (const attn_body::bf16*)(BIG + 2 * SL), (attn_body::bf16*)BIG};
#if !defined(PROBE_NO_FOX)
              attn_body::attn_queue<8>((char*)lds + RING_OFF, AT, CN2, (unsigned*)(F.ctl + CW_QUEUE + 512 * ll), F.MISC + 12);
#endif
            }
            SEAM(pb + 3); }
        if (IN(pb + 5)) { SITE_CTX(l); PROBE_T0();
            { pg8::Gemm g{BIG, (const bf16*)(wl + WT_UPF), M, DM, 512}; pg8::ChainOrder S; S.init(M, DM, gG, gB); S.A2 = BIG + 6 * SL; S.B2 = (const bf16*)(wl + WT_UPM);
              pg8::EpiChain E{BIG + SL, (const unsigned char*)(BIG + 3 * SL), (const unsigned char*)(BIG + 4 * SL)};
#if SITE_ON(3)
              pg8::gemm_phase<pg8::EpiChain, pg8::ChainOrder, true, true>(F.lds + RING_OFF, g, S, E);
#endif
            }
            SEAM(pb + 5);
        }
        if (IN(pb + 8)) { SITE_CTX(l); PROBE_T0();
            pg8::Gemm g{BIG + SL, (const bf16*)(wl + WT_MIX), M, DM, DM}; pg8::StaticOrder S; S.init(M, DM, gG, gB);
            pg8::EpiResidB E{XN, DM, (float*)(ws + WS_SSP), F.lds + RSL_OFF};

#if SITE_ON(7)
STAGGER(22);
#if defined(PROBE_EPI)
            if (blockIdx.x == 0 && threadIdx.x == PROBE_EPI_TID) F.MISC[20] = 1u; __syncthreads();
#endif
pg8::gemm_phase<pg8::EpiResidB, pg8::StaticOrder, true, true>(F.lds + RING_OFF, g, S, E);
#if defined(PROBE_EPI)
            __syncthreads(); if (blockIdx.x == 0 && threadIdx.x == PROBE_EPI_TID) F.MISC[20] = 0u;
#endif
#endif

            SEAM(pb + 8);
        }
        if (IN(pb + 10)) { SITE_CTX(l); PROBE_T0();
            pg8::Gemm g{XN, BIG + 7 * SL, M, DM, DM}; pg8::BatchBOrder S; S.init(M, DM, gG, gB);
            pg8::EpiSoftmax E{BIG, (const float*)(ws + WS_SSP), (LAS float*)(F.lds + RSL_OFF), (LAS float*)(F.lds + RED_OFF)};
#if SITE_ON(8)
            pg8::gemm_phase<pg8::EpiSoftmax, pg8::BatchBOrder, true, true>(F.lds + RING_OFF, g, S, E);
#endif
            SEAM(pb + 10);
        }
        if (IN(pb + 12)) { SITE_CTX(l); PROBE_T0();
            pg8::Gemm g{BIG, BIG + 7 * SL + SL / 2, M, DM, DM}; pg8::BatchBOrder S; S.init(M, DM, gG, gB);
            pg8::EpiResidB E{XN, DM, (float*)(ws + WS_SSP), F.lds + RSL_OFF};
#if SITE_ON(9)
            pg8::gemm_phase<pg8::EpiResidB, pg8::BatchBOrder, true, true>(F.lds + RING_OFF, g, S, E);
#endif
            SEAM(pb + 12);
        }
        if (IN(pb + 14)) { SITE_CTX(l); PROBE_T0();
            pg8::Gemm g{XN, (const bf16*)(wl + WT_M1), M, DFF, DM}; pg8::StaticOrder S; S.init(M, DFF, gG, gB);
            pg8::EpiB<4, true> E{BIG, DFF, nullptr, nullptr, nullptr, (const float*)(ws + WS_SSP), (LAS float*)(F.lds + RSL_OFF)};

#if SITE_ON(10)
STAGGER_N(4, 7);
pg8::gemm_phase<pg8::EpiB<4, true>, pg8::StaticOrder, true, true>(F.lds + RING_OFF, g, S, E);
#endif

            SEAM(pb + 14);
        }
        if (IN(pb + 15)) { SITE_CTX(l); PROBE_T0();
            pg8::Gemm g{BIG, (const bf16*)(wl + WT_M2), M, DM, DFF}; pg8::StaticOrder S; S.init(M, DM, gG, gB);
            pg8::EpiResidB E{XN, DM, (ll < DEPTH - 1) ? (float*)(ws + WS_SSP) : (float*)nullptr, F.lds + RSL_OFF};

#if SITE_ON(11)
pg8::gemm_phase<pg8::EpiResidB, pg8::StaticOrder, true, true>(F.lds + RING_OFF, g, S, E);
#endif

            SEAM(pb + 15);
        }
    }
    if (IN(NPH - 1)) { SITE_CTX(0); PROBE_T0(); final_norm(Fl, XN, out, INP(22));
#if defined(PROBE_MASK)
        PROBE_ACC(NPH - 1);
        if (((PROBE_MASK >> 19) & 1u) && blockIdx.x == 0 && threadIdx.x == 0) F.MISC[16] = (unsigned)(__builtin_amdgcn_s_memrealtime() - pk0_);
        if (blockIdx.x == 0 && threadIdx.x == 0) { asm volatile("s_waitcnt vmcnt(0)" ::: "memory"); out[0] = out[0] + (float)((int)(F.MISC[16] / (100u * PROBE_DIV)) - (int)(PROBE_OFS)); }
#endif
    }
#undef IN
#undef SEAM
}

extern "C" void kernel_launch(void* const* d_in, const int* in_sizes, int n_in, void* d_out, int out_size, void* d_ws, size_t ws_size, hipStream_t stream) {
    static int grid = 0;
    if (grid == 0) {
        if (n_in != 23 || in_sizes[0] != M * DM || out_size != M * DM || ws_size < WS_END) { fprintf(stderr, "kernel_launch: unexpected problem (n_in %d, in0 %d, out %d, ws %zu); nothing launched\n", n_in, n_in > 0 ? in_sizes[0] : -1, out_size, ws_size); grid = -1; return; }
        int dev = 0, cus = 0, per_cu = 0;
        if (hipGetDevice(&dev) != hipSuccess || hipDeviceGetAttribute(&cus, hipDeviceAttributeMultiprocessorCount, dev) != hipSuccess) { grid = -1; return; }
        if (hipFuncSetAttribute((const void*)trunk_fwd, hipFuncAttributeMaxDynamicSharedMemorySize, LDS_BYTES) != hipSuccess) { fprintf(stderr, "kernel_launch: hipFuncSetAttribute failed\n"); grid = -1; return; }
        if (hipOccupancyMaxActiveBlocksPerMultiprocessor(&per_cu, (const void*)trunk_fwd, NWAVES * 64, LDS_BYTES) != hipSuccess || per_cu < 1)
            fprintf(stderr, "kernel_launch: note: occupancy query reports %d workgroups per CU\n", per_cu);
        (void)hipGetLastError();
        grid = cus;
    }
    if (grid < 0) return;
    if (hipMemsetAsync((char*)d_ws + WS_CTL, 0, CTL_ZERO_BYTES, stream) != hipSuccess) return;
    Args a{};
    for (int i = 0; i < 23; ++i) a.in[i] = (const float*)d_in[i];
    a.out = (float*)d_out; a.ws = (unsigned char*)d_ws;
#if MK_PER_PHASE
    for (int p = 0; p < NPH; ++p) { a.ph_lo = p; a.ph_hi = p + 1; hipLaunchKernelGGL(trunk_fwd, dim3(grid), dim3(NWAVES * 64), LDS_BYTES, stream, a); }
#else
    a.ph_lo = 0; a.ph_hi = NPH; hipLaunchKernelGGL(trunk_fwd, dim3(grid), dim3(NWAVES * 64), LDS_BYTES, stream, a);
#endif
}
```

```cpp
#include <hip/hip_runtime.h>
#include <cstdio>
#include <cstdint>
#include <cmath>
namespace pg8 {
#define PG8_LAS __attribute__((address_space(3)))
typedef unsigned short bf16_t;
typedef short bf16x8 __attribute__((ext_vector_type(8)));
typedef float f32x4 __attribute__((ext_vector_type(4)));
typedef unsigned u32x4 __attribute__((ext_vector_type(4)));
constexpr int BM = 256, BK = 64, HALF = 128, HTB = HALF * BK * 2  , STAGE_BYTES = 8 * HTB, NXCD = 8, WGM = 8;

__host__ __device__ __forceinline__ int lds_byte(int r, int c) { const int st = (r >> 4) * 2 + (c >> 5), rr = r & 15, cc = c & 31, ob = rr * 64 + cc * 2; return st * 1024 + (ob ^ (((ob >> 9) & 1) << 5)); }
__host__ __device__ __forceinline__ void stage_rc(int b, int& R, int& C) { const int st = b / 1024, sb = b % 1024, swz = sb ^ (((sb >> 9) & 1) << 5); R = (st >> 1) * 16 + swz / 64; C = (st & 1) * 32 + (swz % 64) / 2; }
__host__ __device__ __forceinline__ int perm32(int rho) { const int n = rho >> 4, i = rho & 15; return 8 * (i >> 2) + 4 * n + (i & 3); }

struct Unit { int pm, pn; };
struct Gemm { const bf16_t* A; const bf16_t* Bt; int M, N, K; int lda, ldb;
    __host__ __device__ Gemm(const bf16_t* A_, const bf16_t* Bt_, int M_, int N_, int K_) : A(A_), Bt(Bt_), M(M_), N(N_), K(K_), lda(K_), ldb(K_) {}
    __host__ __device__ Gemm(const bf16_t* A_, const bf16_t* Bt_, int M_, int N_, int K_, int lda_, int ldb_) : A(A_), Bt(Bt_), M(M_), N(N_), K(K_), lda(lda_), ldb(ldb_) {} };
#define PG8_DEFAULT_BASES __device__ __forceinline__ const char* abase(const Gemm& g, const Unit& u) const { return (const char*)g.A + (size_t)u.pm * BM * g.lda * 2; } \
    __device__ __forceinline__ const char* bbase(const Gemm& g, const Unit& u) const { return (const char*)g.Bt + (size_t)u.pn * BM * g.ldb * 2; }

struct StaticOrder {
    int nM, nN, nwg, G, c;
    __host__ __device__ void init(int M, int N, int G_, int c_) { nM = M / BM; nN = N / BM; nwg = nM * nN; G = G_; c = c_; }
    __host__ __device__ bool next(int i, Unit& u) const {
        const long L = (long)i * G + c; if (L >= nwg) return false;
        int wgid = (int)L; { const int q = nwg / NXCD, r = nwg % NXCD, xcd = wgid % NXCD, off = wgid / NXCD; wgid = (xcd < r ? xcd * (q + 1) : r * (q + 1) + (xcd - r) * q) + off; }
        const int nig = WGM * nN, gid = wgid / nig, fm = gid * WGM, gsz = (nM - fm) < WGM ? (nM - fm) : WGM;
        u.pm = fm + ((wgid % nig) % gsz); u.pn = (wgid % nig) / gsz; return true;
    }
    __device__ __forceinline__ void a_ready(const Unit&) const {}
    __device__ __forceinline__ void done(const Unit&) const {}
    PG8_DEFAULT_BASES
};

__device__ __forceinline__ unsigned cvt_pk_bf16(float lo, float hi) { unsigned r; asm volatile("v_cvt_pk_bf16_f32 %0, %1, %2" : "=v"(r) : "v"(lo), "v"(hi)); return r; }
typedef float f32x2 __attribute__((ext_vector_type(2)));
__device__ __forceinline__ unsigned pk4f8(float a, float b, float c, float d) { int r = 0; r = __builtin_amdgcn_cvt_pk_fp8_f32(a, b, r, false); r = __builtin_amdgcn_cvt_pk_fp8_f32(c, d, r, true); return (unsigned)r; }
__device__ __forceinline__ float bf2f(unsigned short b) { return __uint_as_float((unsigned)b << 16); }
__device__ __forceinline__ float fsigm(float x) { const float d = 1.0f + __builtin_amdgcn_exp2f(x * -1.4426950408889634f); float r; asm("v_rcp_f32_e32 %0, %1" : "=v"(r) : "v"(d)); return r; }
__device__ __forceinline__ f32x4 sigm4(f32x4 v) { return (f32x4){fsigm(v[0]), fsigm(v[1]), fsigm(v[2]), fsigm(v[3])}; }
__device__ __forceinline__ void unpack8(const u32x4 w, f32x4& a, f32x4& b) {
    a = (f32x4){__uint_as_float(w.x << 16), __uint_as_float(w.x & 0xffff0000u), __uint_as_float(w.y << 16), __uint_as_float(w.y & 0xffff0000u)};
    b = (f32x4){__uint_as_float(w.z << 16), __uint_as_float(w.z & 0xffff0000u), __uint_as_float(w.w << 16), __uint_as_float(w.w & 0xffff0000u)};
}
__device__ __forceinline__ float fq_sum(float v) {
    { auto r = __builtin_amdgcn_permlane16_swap(__float_as_uint(v), __float_as_uint(v), false, false); v = __uint_as_float(r[0]) + __uint_as_float(r[1]); }
    { auto r = __builtin_amdgcn_permlane32_swap(__float_as_uint(v), __float_as_uint(v), false, false); v = __uint_as_float(r[0]) + __uint_as_float(r[1]); }
    return v;
}

__device__ __forceinline__ void rs_stage(const float* ssp, PG8_LAS float* rsl, const Unit& u, int wid, int lane) {
    int l4 = lane * 4; asm volatile("" : "+v"(l4));
#pragma unroll
    for (int j = 0; j < 2; ++j) { const int r0 = 32 * wid + 16 * j;
        __builtin_amdgcn_global_load_lds((const unsigned*)(ssp + (size_t)(u.pm * BM + r0) * 16 + l4), (PG8_LAS unsigned*)(rsl + r0 * 16), 16, 0, 0); }
}
__device__ __forceinline__ void rs_scale(float (&rsc)[2][4], const PG8_LAS float* rsl, int wr, int fr, int fq) {
    int lo_ = (wr * 64 + fr) * 16 + 4 * fq; asm volatile("" : "+v"(lo_));
    const PG8_LAS float* bp = rsl + lo_;
#pragma unroll
    for (int ai = 0; ai < 2; ++ai)
#pragma unroll
        for (int m = 0; m < 4; ++m) { const f32x4 p = *(const PG8_LAS f32x4*)(bp + (ai * HALF + m * 16) * 16); rsc[ai][m] = (p[0] + p[1]) + (p[2] + p[3]); }
#pragma unroll
    for (int ai = 0; ai < 2; ++ai)
#pragma unroll
        for (int m = 0; m < 4; ++m) rsc[ai][m] = __builtin_amdgcn_rsqf(fq_sum(rsc[ai][m]) * (1.0f / 1024.0f) + 1e-6f);
}
template <int MODE, bool RS = false> struct EpiB {
    static constexpr bool PERM = true, AFTER_DRAIN = false, STAGE = RS; static constexpr bool CHAIN = false;
    bf16_t* O; int ldc; const float* bias; const bf16_t* G; const bf16_t* T; const float* ssp; PG8_LAS float* rsl;
    __device__ __forceinline__ void stage(const Unit& u, int wid, int lane) const { rs_stage(ssp, rsl, u, wid, lane); }
    __device__ __forceinline__ void operator()(const f32x4 (&acc)[2][2][4][2], const Unit& u, int wr, int wc, int fr, int fq) const {
        bf16_t* base = O; int ld = ldc; int colt = u.pn * BM;
        if (MODE == 5) {
            const int pn = u.pn; int slot;
            if (pn < 6) { slot = pn >> 1; ld = 512; colt = (pn & 1) * 256; }
            else if (pn < 10) { slot = 3; ld = 1024; colt = (pn - 6) * 256; }
            else { slot = 5 + ((pn - 10) >> 1); ld = 512; colt = ((pn - 10) & 1) * 256; }
            base = O + (size_t)slot * 33554432u;
        }
        if (MODE == 6) { base = O + (size_t)(u.pn >> 2) * 67108864u; colt = (u.pn & 3) * BM; }
        const int row0 = u.pm * BM + wr * 64 + fr;
        const int col0 = colt + wc * 32 + 8 * fq, bcol0 = u.pn * BM + wc * 32 + 8 * fq;
        f32x4 bv[2][2];
#pragma unroll
        for (int bj = 0; bj < 2; ++bj)
#pragma unroll
            for (int n = 0; n < 2; ++n) bv[bj][n] = (MODE == 1 || MODE == 6) ? *(const f32x4*)(bias + bcol0 + bj * HALF + 4 * n) : (f32x4){0.f, 0.f, 0.f, 0.f};
        float rsc[2][4];
        if (RS) rs_scale(rsc, rsl, wr, fr, fq);
        constexpr int GW = (MODE == 2) ? 8 : 4;
        u32x4 ga[GW][2], tc[2], tn[2];
        if (MODE == 2 || MODE == 3) {
#pragma unroll
            for (int it = 0; it < GW; ++it)
#pragma unroll
                for (int bj = 0; bj < 2; ++bj) ga[it][bj] = *(const u32x4*)(G + (size_t)(row0 + (it >> 2) * HALF + (it & 3) * 16) * ld + col0 + bj * HALF);
            if (MODE == 3) {
#pragma unroll
                for (int bj = 0; bj < 2; ++bj) tc[bj] = *(const u32x4*)(T + (size_t)row0 * ld + col0 + bj * HALF); } }
#pragma unroll
        for (int it = 0; it < 8; ++it) { const int ai = it >> 2, m = it & 3; const size_t roff = (size_t)(row0 + ai * HALF + m * 16) * ld + col0;
            if (MODE == 3 && it < 7) { const int ai2 = (it + 1) >> 2, m2 = (it + 1) & 3; const size_t roff2 = (size_t)(row0 + ai2 * HALF + m2 * 16) * ld + col0;
#pragma unroll
                for (int bj = 0; bj < 2; ++bj) tn[bj] = *(const u32x4*)(T + roff2 + bj * HALF); }
            if (MODE == 3) asm volatile("" ::: "memory");
#pragma unroll
            for (int bj = 0; bj < 2; ++bj) { f32x4 v0 = acc[ai][bj][m][0], v1 = acc[ai][bj][m][1];
                if (RS) { v0 = v0 * rsc[ai][m]; v1 = v1 * rsc[ai][m]; }
                if (MODE == 1 || MODE == 6) { v0 = sigm4(v0 + bv[bj][0]); v1 = sigm4(v1 + bv[bj][1]); }
                if (MODE == 2 || MODE == 3) { f32x4 g0, g1; unpack8(ga[it % GW][bj], g0, g1); v0 = v0 * g0; v1 = v1 * g1;
                    if (it + GW < 8) ga[it % GW][bj] = *(const u32x4*)(G + (size_t)(row0 + ((it + GW) >> 2) * HALF + ((it + GW) & 3) * 16) * ld + col0 + bj * HALF); }
                if (MODE == 3) { f32x4 t0, t1; unpack8(tc[bj], t0, t1); v0 = v0 + t0; v1 = v1 + t1; }
                if (MODE == 4) { v0 = __builtin_elementwise_max(v0, (f32x4){0.f, 0.f, 0.f, 0.f}); v1 = __builtin_elementwise_max(v1, (f32x4){0.f, 0.f, 0.f, 0.f}); v0 = v0 * v0; v1 = v1 * v1; }
                u32x4 w; w.x = cvt_pk_bf16(v0[0], v0[1]); w.y = cvt_pk_bf16(v0[2], v0[3]); w.z = cvt_pk_bf16(v1[0], v1[1]); w.w = cvt_pk_bf16(v1[2], v1[3]);
                if (MODE == 7) {
                    const int tb = u.pm * 8 + 2 * wr + 4 * ai + (m >> 1), ks = 2 * wc + (fq >> 1) + 8 * bj;
                    *(u32x4*)(O + ((size_t)((tb * 4 + u.pn) * 16 + ks) * 64 + (fq & 1) * 32 + 16 * (m & 1) + fr) * 8) = w; }
                else *(u32x4*)(base + roff + bj * HALF) = w;
                }
            if (MODE == 3) { asm volatile("" ::: "memory");
#pragma unroll
                for (int bj = 0; bj < 2; ++bj) tc[bj] = tn[bj]; }
        }
    }
};
template <bool STATS> struct EpiResid {
    static constexpr bool PERM = false, AFTER_DRAIN = false, STAGE = false; static constexpr bool CHAIN = false;
    const float* hin; float* out; int ldc; bf16_t* hb; float* ssp;
    __device__ __forceinline__ void operator()(const f32x4 (&acc)[2][2][4][2], const Unit& u, int wr, int wc, int fr, int fq) const {
        const int row0 = u.pm * BM + wr * 64 + fr, col0 = u.pn * BM + wc * 32 + 4 * fq;
        f32x4 rc[2][2], rn[2][2];
#pragma unroll
        for (int bj = 0; bj < 2; ++bj)
#pragma unroll
            for (int n = 0; n < 2; ++n) rc[bj][n] = *(const f32x4*)(hin + (size_t)row0 * ldc + col0 + bj * HALF + n * 16);
#pragma unroll
        for (int it = 0; it < 8; ++it) { const int ai = it >> 2, m = it & 3; const size_t off = (size_t)(row0 + ai * HALF + m * 16) * ldc + col0;
            if (it < 7) { const int ai2 = (it + 1) >> 2, m2 = (it + 1) & 3; const size_t off2 = (size_t)(row0 + ai2 * HALF + m2 * 16) * ldc + col0;
#pragma unroll
                for (int bj = 0; bj < 2; ++bj)
#pragma unroll
                    for (int n = 0; n < 2; ++n) rn[bj][n] = *(const f32x4*)(hin + off2 + bj * HALF + n * 16); }
            asm volatile("" ::: "memory");
#pragma unroll
            for (int bj = 0; bj < 2; ++bj)
#pragma unroll
                for (int n = 0; n < 2; ++n) { rc[bj][n] = rc[bj][n] + acc[ai][bj][m][n]; *(f32x4*)(out + off + bj * HALF + n * 16) = rc[bj][n]; }
            if (STATS && hb) { float ss = 0.f;
#pragma unroll
                for (int bj = 0; bj < 2; ++bj)
#pragma unroll
                    for (int n = 0; n < 2; ++n) { const f32x4 v = rc[bj][n]; ss += (v[0] * v[0] + v[1] * v[1]) + (v[2] * v[2] + v[3] * v[3]);
                        typedef unsigned u32x2 __attribute__((ext_vector_type(2))); *(u32x2*)(hb + off + bj * HALF + n * 16) = (u32x2){cvt_pk_bf16(v[0], v[1]), cvt_pk_bf16(v[2], v[3])}; }
                ss = fq_sum(ss);
                if (fq == 0) ssp[(size_t)(row0 + ai * HALF + m * 16) * 16 + 4 * u.pn + wc] = ss; }
            asm volatile("" ::: "memory");
#pragma unroll
            for (int bj = 0; bj < 2; ++bj)
#pragma unroll
                for (int n = 0; n < 2; ++n) rc[bj][n] = rn[bj][n];
        }
    }
};

template <bool HAS8 = false, bool SCALED = false, bool NAT8 = false> struct EpiResidBT {
    static constexpr bool PERM = true, AFTER_DRAIN = false, STAGE = false; static constexpr bool CHAIN = false;
    bf16_t* H; int ldc; float* ssp; unsigned char* H8; static constexpr float asc = SCALED ? 1.0f / 4096.0f : 1.0f;
    __device__ __forceinline__ void operator()(const f32x4 (&acc)[2][2][4][2], const Unit& u, int wr, int wc, int fr, int fq) const {
        const int row0 = u.pm * BM + wr * 64 + fr, col0 = u.pn * BM + wc * 32 + 8 * fq;
        u32x4 hc[2], hn[2];
#pragma unroll
        for (int bj = 0; bj < 2; ++bj) hc[bj] = *(const u32x4*)(H + (size_t)row0 * ldc + col0 + bj * HALF);
#pragma unroll
        for (int it = 0; it < 8; ++it) { const int ai = it >> 2, m = it & 3; const size_t off = (size_t)(row0 + ai * HALF + m * 16) * ldc + col0;
            if (it < 7) { const int ai2 = (it + 1) >> 2, m2 = (it + 1) & 3; const size_t off2 = (size_t)(row0 + ai2 * HALF + m2 * 16) * ldc + col0;
#pragma unroll
                for (int bj = 0; bj < 2; ++bj) hn[bj] = *(const u32x4*)(H + off2 + bj * HALF); }
            asm volatile("" ::: "memory");
            float ss = 0.f; u32x4 w8;
#pragma unroll
            for (int bj = 0; bj < 2; ++bj) { f32x4 h0, h1; unpack8(hc[bj], h0, h1); const f32x4 v0 = SCALED ? h0 + acc[ai][bj][m][0] * asc : h0 + acc[ai][bj][m][0], v1 = SCALED ? h1 + acc[ai][bj][m][1] * asc : h1 + acc[ai][bj][m][1];
                ss += ((v0[0] * v0[0] + v0[1] * v0[1]) + (v0[2] * v0[2] + v0[3] * v0[3])) + ((v1[0] * v1[0] + v1[1] * v1[1]) + (v1[2] * v1[2] + v1[3] * v1[3]));
                u32x4 w; w.x = cvt_pk_bf16(v0[0], v0[1]); w.y = cvt_pk_bf16(v0[2], v0[3]); w.z = cvt_pk_bf16(v1[0], v1[1]); w.w = cvt_pk_bf16(v1[2], v1[3]);
                *(u32x4*)(H + off + bj * HALF) = w;
                if (HAS8 && H8) { int a = 0, b = 0; a = __builtin_amdgcn_cvt_pk_fp8_f32(v0[0], v0[1], a, false); a = __builtin_amdgcn_cvt_pk_fp8_f32(v0[2], v0[3], a, true); b = __builtin_amdgcn_cvt_pk_fp8_f32(v1[0], v1[1], b, false); b = __builtin_amdgcn_cvt_pk_fp8_f32(v1[2], v1[3], b, true);
                    if (NAT8) { if (bj == 0) { w8.x = (unsigned)a; w8.y = (unsigned)b; } else { w8.z = (unsigned)a; w8.w = (unsigned)b; } }
                    else { typedef unsigned u32x2_ __attribute__((ext_vector_type(2))); *(u32x2_*)(H8 + off + bj * HALF) = (u32x2_){(unsigned)a, (unsigned)b}; } } }
            if (HAS8 && NAT8 && H8) *(u32x4*)(H8 + (size_t)(row0 + ai * HALF + m * 16) * ldc + u.pn * BM + wc * 64 + 16 * fq) = w8;
            if (ssp) { ss = fq_sum(ss); if (fq == 0) ssp[(size_t)(row0 + ai * HALF + m * 16) * 16 + 4 * u.pn + wc] = ss; }
            asm volatile("" ::: "memory");
#pragma unroll
            for (int bj = 0; bj < 2; ++bj) hc[bj] = hn[bj];
        }
    }
};
typedef EpiResidBT<false, false> EpiResidB;

__device__ __forceinline__ float logsig(float x) { return fminf(x, 0.f) - log1pf(expf(-fabsf(x))); }
struct EpiIn {
    static constexpr bool PERM = true, AFTER_DRAIN = false, STAGE = true; static constexpr bool CHAIN = false;
    PG8_LAS float* rsl;
    __device__ __forceinline__ void stage(const Unit& u, int wid, int lane) const { rs_stage(ssp, rsl, u, wid, lane); }
    bf16_t* O; const float* ssp; float* ffl; float* ig; float* lf; const float* bff; const float* bmi; const float* bmf;
    __device__ __forceinline__ void operator()(const f32x4 (&acc)[2][2][4][2], const Unit& u, int wr, int wc, int fr, int fq) const {
        const int pn = u.pn; const int row0 = u.pm * BM + wr * 64 + fr;
        float rsc[2][4]; rs_scale(rsc, rsl, wr, fr, fq);
        int slot, ld, colt;
        if (pn < 6) { slot = pn >> 1; ld = 512; colt = (pn & 1) * 256; }
        else if (pn < 10) { slot = 3; ld = 1024; colt = (pn - 6) * 256; }
        else { slot = 5 + ((pn - 10) >> 1); ld = 512; colt = ((pn - 10) & 1) * 256; }
        bf16_t* base = O + (size_t)slot * 33554432u;
        const int col0 = colt + wc * 32 + 8 * fq;
#pragma unroll
        for (int ai = 0; ai < 2; ++ai)
#pragma unroll
            for (int m = 0; m < 4; ++m) { const size_t roff = (size_t)(row0 + ai * HALF + m * 16) * ld + col0;
#pragma unroll
                for (int bj = 0; bj < 2; ++bj) { f32x4 v0 = acc[ai][bj][m][0] * rsc[ai][m], v1 = acc[ai][bj][m][1] * rsc[ai][m];
                    if (pn >= 12) { v0 = sigm4(v0); v1 = sigm4(v1); }
                    u32x4 w; w.x = cvt_pk_bf16(v0[0], v0[1]); w.y = cvt_pk_bf16(v0[2], v0[3]); w.z = cvt_pk_bf16(v1[0], v1[1]); w.w = cvt_pk_bf16(v1[2], v1[3]);
                    *(u32x4*)(base + roff + bj * HALF) = w; } }
    }
};

struct DiagOrder {
    int G, c; bool xk;
    __device__ __forceinline__ bool next(int i, Unit& u) const {
        const int L = i * G + c; if (L >= 256) return false;
        const int layer = L >> 6, rem = L & 63;
        if (xk) { u.pm = layer * 16 + (rem >> 2); u.pn = layer * 4 + (rem & 3); } else { u.pm = layer * 4 + (rem >> 4); u.pn = layer * 16 + (rem & 15); }
        return true;
    }
    __device__ __forceinline__ void a_ready(const Unit&) const {}
    __device__ __forceinline__ void done(const Unit&) const {}
    PG8_DEFAULT_BASES
};

struct GateOrder {
    StaticOrder so;
    __device__ __forceinline__ void init(int M, int G_, int c_) { so.init(M, 1024, G_, c_); }
    __device__ __forceinline__ bool next(int i, Unit& u) const { if (!so.next(i >> 1, u)) return false; u.pn += 4 * (i & 1); return true; }
    __device__ __forceinline__ void a_ready(const Unit&) const {}
    __device__ __forceinline__ void done(const Unit&) const {}
    PG8_DEFAULT_BASES
};

typedef unsigned u32x2 __attribute__((ext_vector_type(2)));
__device__ __forceinline__ unsigned pack_u8x4(f32x4 g) {
    const f32x4 t = __builtin_elementwise_roundeven(g * 255.0f);
    unsigned r = 0u;
    r = __builtin_amdgcn_cvt_pk_u8_f32(t[0], 0u, r); r = __builtin_amdgcn_cvt_pk_u8_f32(t[1], 1u, r); r = __builtin_amdgcn_cvt_pk_u8_f32(t[2], 2u, r); r = __builtin_amdgcn_cvt_pk_u8_f32(t[3], 3u, r);
    return r;
}
__device__ __forceinline__ f32x4 unpack_u8x4(unsigned w) {
    return (f32x4){(float)(w & 0xffu), (float)((w >> 8) & 0xffu), (float)((w >> 16) & 0xffu), (float)(w >> 24)};
}
struct EpiGate8 {
    static constexpr bool PERM = true, AFTER_DRAIN = false, STAGE = true; static constexpr bool CHAIN = false;
    unsigned char* G0; unsigned char* G1; const float* bias; const float* ssp; PG8_LAS float* rsl; float wsc;
    __device__ __forceinline__ void stage(const Unit& u, int wid, int lane) const { rs_stage(ssp, rsl, u, wid, lane); }
    __device__ __forceinline__ void operator()(const f32x4 (&acc)[2][2][4][2], const Unit& u, int wr, int wc, int fr, int fq) const {
        unsigned char* base = (u.pn >> 2) ? G1 : G0; const int colt = (u.pn & 3) * BM;
        const int row0 = u.pm * BM + wr * 64 + fr, col0 = colt + wc * 32 + 8 * fq, bcol0 = u.pn * BM + wc * 32 + 8 * fq;
        f32x4 bv[2][2];
#pragma unroll
        for (int bj = 0; bj < 2; ++bj)
#pragma unroll
            for (int n = 0; n < 2; ++n) bv[bj][n] = *(const f32x4*)(bias + bcol0 + bj * HALF + 4 * n);
        float rsc[2][4]; rs_scale(rsc, rsl, wr, fr, fq);
#pragma unroll
        for (int ai = 0; ai < 2; ++ai)
#pragma unroll
            for (int m = 0; m < 4; ++m) rsc[ai][m] *= wsc;
#pragma unroll
        for (int ai = 0; ai < 2; ++ai)
#pragma unroll
            for (int m = 0; m < 4; ++m) { const size_t roff = (size_t)(row0 + ai * HALF + m * 16) * 1024 + colt + wc * 64 + 16 * fq;
                u32x4 w;
#pragma unroll
                for (int bj = 0; bj < 2; ++bj) { const f32x4 v0 = sigm4(acc[ai][bj][m][0] * rsc[ai][m] + bv[bj][0]), v1 = sigm4(acc[ai][bj][m][1] * rsc[ai][m] + bv[bj][1]);
                    if (bj == 0) { w.x = pack_u8x4(v0); w.y = pack_u8x4(v1); } else { w.z = pack_u8x4(v0); w.w = pack_u8x4(v1); } }
                *(u32x4*)(base + roff) = w; }
    }
};
template <bool ADD> struct EpiMerge8 {
    static constexpr bool PERM = true, AFTER_DRAIN = false, STAGE = false; static constexpr bool CHAIN = false;
    bf16_t* T; const unsigned char* G8;
    __device__ __forceinline__ void operator()(const f32x4 (&acc)[2][2][4][2], const Unit& u, int wr, int wc, int fr, int fq) const {
        const int row0 = u.pm * BM + wr * 64 + fr, col0 = u.pn * BM + wc * 32 + 8 * fq;
        u32x4 ga[8]; u32x4 tc[2], tn[2];
#pragma unroll
        for (int it = 0; it < 8; ++it) ga[it] = *(const u32x4*)(G8 + (size_t)(row0 + (it >> 2) * HALF + (it & 3) * 16) * 1024 + u.pn * BM + wc * 64 + 16 * fq);
        if (ADD) {
#pragma unroll
            for (int bj = 0; bj < 2; ++bj) tc[bj] = *(const u32x4*)(T + (size_t)row0 * 1024 + col0 + bj * HALF); }
#pragma unroll
        for (int it = 0; it < 8; ++it) { const int ai = it >> 2, m = it & 3; const size_t roff = (size_t)(row0 + ai * HALF + m * 16) * 1024 + col0;
            if (ADD && it < 7) { const size_t roff2 = (size_t)(row0 + ((it + 1) >> 2) * HALF + ((it + 1) & 3) * 16) * 1024 + col0;
#pragma unroll
                for (int bj = 0; bj < 2; ++bj) tn[bj] = *(const u32x4*)(T + roff2 + bj * HALF); }
            if (ADD) asm volatile("" ::: "memory");
#pragma unroll
            for (int bj = 0; bj < 2; ++bj) { f32x4 v0 = acc[ai][bj][m][0] * (unpack_u8x4(bj ? ga[it].z : ga[it].x) * (1.0f / 255.0f)), v1 = acc[ai][bj][m][1] * (unpack_u8x4(bj ? ga[it].w : ga[it].y) * (1.0f / 255.0f));
                if (ADD) { f32x4 t0, t1; unpack8(tc[bj], t0, t1); v0 = v0 + t0; v1 = v1 + t1; }
                u32x4 w; w.x = cvt_pk_bf16(v0[0], v0[1]); w.y = cvt_pk_bf16(v0[2], v0[3]); w.z = cvt_pk_bf16(v1[0], v1[1]); w.w = cvt_pk_bf16(v1[2], v1[3]);
                *(u32x4*)(T + roff + bj * HALF) = w; }
            if (ADD) { asm volatile("" ::: "memory");
#pragma unroll
                for (int bj = 0; bj < 2; ++bj) tc[bj] = tn[bj]; }
        }
    }
};

#ifndef SKEW_A
#define SKEW_A 10
#define SKEW_B 2
#endif
static_assert(24 * SKEW_A + 8 * SKEW_B == 256, "SkewOrder: 24 a + 8 b units per XCD");
struct SkewOrder {
    StaticOrder so; int G, c; bool skew;
    __device__ __forceinline__ void init(int M, int G_, int c_) { so.init(M, 2048, G_, c_); G = G_; c = c_; skew = (G_ == 256); }
    __device__ __forceinline__ bool next(int i, Unit& u) const {
        if (!skew) return so.next(i, u);
        const int x = c & 7, j = c >> 3; int lu;
        if ((j & 3) == 0) { if (i >= SKEW_B) return false; lu = 24 * SKEW_A + SKEW_B * (j >> 2) + i; }
        else { if (i >= SKEW_A) return false; lu = (j - (j >> 2) - 1) + 24 * i; }
        u.pm = 8 * (lu >> 3) + x; u.pn = lu & 7; return true;
    }
    __device__ __forceinline__ void a_ready(const Unit&) const {}
    __device__ __forceinline__ void done(const Unit&) const {}
    PG8_DEFAULT_BASES
};

struct BatchBOrder {
    StaticOrder so;
    __device__ __forceinline__ void init(int M, int N, int G_, int c_) { so.init(M, N, G_, c_); }
    __device__ __forceinline__ bool next(int i, Unit& u) const { return so.next(i, u); }
    __device__ __forceinline__ void a_ready(const Unit&) const {}
    __device__ __forceinline__ void done(const Unit&) const {}
    __device__ __forceinline__ const char* abase(const Gemm& g, const Unit& u) const { return (const char*)g.A + (size_t)u.pm * BM * g.lda * 2; }
    __device__ __forceinline__ const char* bbase(const Gemm& g, const Unit& u) const { return (const char*)g.Bt + ((size_t)(u.pm >> 4) * 1024 + (size_t)u.pn * BM) * g.ldb * 2; }
};
struct XPreOrder {
    int G, c; const bf16_t* A2; const bf16_t* B2;
    __device__ __forceinline__ bool next(int i, Unit& u) const { const int L = i * G + c; if (L >= 512) return false;
        if (L < 256) { u.pm = L >> 2; u.pn = L & 3; } else { const int L2 = L - 256; u.pm = 64 + (L2 >> 4) * 4 + ((L2 >> 2) & 3); u.pn = L2 & 3; } return true; }
    __device__ __forceinline__ void a_ready(const Unit&) const {}
    __device__ __forceinline__ void done(const Unit&) const {}
    __device__ __forceinline__ const char* abase(const Gemm& g, const Unit& u) const {
        if (u.pm < 64) return (const char*)g.A + ((size_t)(u.pm >> 2) * 256 * 1024 + (size_t)(u.pm & 3) * 256) * 2;
        return (const char*)A2 + ((size_t)(u.pm & 3) * 256 * 1024 + (size_t)u.pn * 256) * 2; }
    __device__ __forceinline__ const char* bbase(const Gemm& g, const Unit& u) const {
        if (u.pm < 64) return (const char*)g.Bt + ((size_t)u.pn * 256 * 1024 + (size_t)(u.pm & 3) * 256) * 2;
        return (const char*)B2 + ((size_t)((u.pm - 64) >> 2) * 256 * 1024 + (size_t)u.pn * 256) * 2; }
};
__device__ __forceinline__ float fq_max(float v) {
    { auto r = __builtin_amdgcn_permlane16_swap(__float_as_uint(v), __float_as_uint(v), false, false); v = fmaxf(__uint_as_float(r[0]), __uint_as_float(r[1])); }
    { auto r = __builtin_amdgcn_permlane32_swap(__float_as_uint(v), __float_as_uint(v), false, false); v = fmaxf(__uint_as_float(r[0]), __uint_as_float(r[1])); }
    return v;
}
constexpr float WK8_SCALE = 32.f;
constexpr float P8_SCALE = 256.f, VW8_SCALE = 16.f;
static_assert(P8_SCALE * VW8_SCALE == 4096.f, "EpiResidBT<.., true> divides by 4096");
struct EpiSoftmax {
    static constexpr bool PERM = true, AFTER_DRAIN = false, STAGE = true; static constexpr bool CHAIN = false;
    bf16_t* O; const float* ssp; PG8_LAS float* rsl; PG8_LAS float* red;
    __device__ __forceinline__ void stage(const Unit& u, int wid, int lane) const { rs_stage(ssp, rsl, u, wid, lane); }
    __device__ __forceinline__ void operator()(const f32x4 (&acc)[2][2][4][2], const Unit& u, int wr, int wc, int fr, int fq) const {
        float rsc[2][4]; rs_scale(rsc, rsl, wr, fr, fq);
#pragma unroll
        for (int ai = 0; ai < 2; ++ai)
#pragma unroll
            for (int m = 0; m < 4; ++m) rsc[ai][m] *= (1.0f / WK8_SCALE);
        int rl0 = (wr * 64 + fr) * 8; asm volatile("" : "+v"(rl0));
        float mw[2][4];
#pragma unroll
        for (int ai = 0; ai < 2; ++ai)
#pragma unroll
            for (int m = 0; m < 4; ++m) { float t = -INFINITY;
#pragma unroll
                for (int bj = 0; bj < 2; ++bj)
#pragma unroll
                    for (int n = 0; n < 2; ++n) { const f32x4 v = acc[ai][bj][m][n] * rsc[ai][m]; t = fmaxf(fmaxf(t, fmaxf(v[0], v[1])), fmaxf(v[2], v[3])); }
                t = fq_max(t); mw[ai][m] = t;
                float s = 0.f;
#pragma unroll
                for (int bj = 0; bj < 2; ++bj)
#pragma unroll
                    for (int n = 0; n < 2; ++n) { const f32x4 v = acc[ai][bj][m][n] * rsc[ai][m] - t;
                        s += (__builtin_amdgcn_exp2f(v[0]) + __builtin_amdgcn_exp2f(v[1])) + (__builtin_amdgcn_exp2f(v[2]) + __builtin_amdgcn_exp2f(v[3])); }
                s = fq_sum(s);
                if (fq == 0) { typedef float f32x2 __attribute__((ext_vector_type(2))); *(PG8_LAS f32x2*)(red + rl0 + (ai * HALF + m * 16) * 8 + 2 * wc) = (f32x2){t, s}; } }
        asm volatile("s_waitcnt lgkmcnt(0)" ::: "memory"); __builtin_amdgcn_s_barrier(); asm volatile("" ::: "memory");
        const int row0 = u.pm * BM + wr * 64 + fr, gcol = u.pn * BM + wc * 64 + 16 * fq;
#pragma unroll
        for (int ai = 0; ai < 2; ++ai)
#pragma unroll
            for (int m = 0; m < 4; ++m) { const f32x4 qa = *(const PG8_LAS f32x4*)(red + rl0 + (ai * HALF + m * 16) * 8), qb = *(const PG8_LAS f32x4*)(red + rl0 + (ai * HALF + m * 16) * 8 + 4);
                const float mm = fmaxf(fmaxf(qa[0], qa[2]), fmaxf(qb[0], qb[2]));
                const float l = (qa[1] * __builtin_amdgcn_exp2f(qa[0] - mm) + qa[3] * __builtin_amdgcn_exp2f(qa[2] - mm)) + (qb[1] * __builtin_amdgcn_exp2f(qb[0] - mm) + qb[3] * __builtin_amdgcn_exp2f(qb[2] - mm));
                float inv; asm("v_rcp_f32_e32 %0, %1" : "=v"(inv) : "v"(l));
                const float f = __builtin_amdgcn_exp2f(mw[ai][m] - mm) * inv * P8_SCALE, t = mw[ai][m];
                u32x4 w;
#pragma unroll
                for (int bj = 0; bj < 2; ++bj) { const f32x4 v0 = acc[ai][bj][m][0] * rsc[ai][m] - t, v1 = acc[ai][bj][m][1] * rsc[ai][m] - t;
                    const unsigned lo = pk4f8(__builtin_amdgcn_exp2f(v0[0]) * f, __builtin_amdgcn_exp2f(v0[1]) * f, __builtin_amdgcn_exp2f(v0[2]) * f, __builtin_amdgcn_exp2f(v0[3]) * f);
                    const unsigned hi = pk4f8(__builtin_amdgcn_exp2f(v1[0]) * f, __builtin_amdgcn_exp2f(v1[1]) * f, __builtin_amdgcn_exp2f(v1[2]) * f, __builtin_amdgcn_exp2f(v1[3]) * f);
                    if (bj == 0) { w.x = lo; w.y = hi; } else { w.z = lo; w.w = hi; } }
                *(u32x4*)((unsigned char*)O + (size_t)(row0 + ai * HALF + m * 16) * 1024 + gcol) = w; }
    }
};

struct ChainOrder {
    StaticOrder so; const bf16_t* A2; const bf16_t* B2;
    __device__ __forceinline__ void init(int M, int N, int G_, int c_) { so.init(M, N, G_, c_); }
    __device__ __forceinline__ bool next(int i, Unit& u) const { if (!so.next(i >> 1, u)) return false; u.pn |= (i & 1) << 8; return true; }
    __device__ __forceinline__ void a_ready(const Unit&) const {}
    __device__ __forceinline__ void done(const Unit&) const {}
    __device__ __forceinline__ const char* abase(const Gemm& g, const Unit& u) const { return (const char*)((u.pn >> 8) ? A2 : g.A) + (size_t)u.pm * BM * g.lda * 2; }
    __device__ __forceinline__ const char* bbase(const Gemm& g, const Unit& u) const { return (const char*)((u.pn >> 8) ? B2 : g.Bt) + (size_t)(u.pn & 255) * BM * g.ldb * 2; }
};
struct EpiChain {
    static constexpr bool PERM = true, AFTER_DRAIN = false, STAGE = false, CHAIN = true;
    bf16_t* T; const unsigned char* Gf; const unsigned char* Gm;
    static __device__ __forceinline__ f32x4 den4(unsigned w) { const f32x4 g = unpack_u8x4(w); return (f32x4){fmaxf(g[0], 1.f), fmaxf(g[1], 1.f), fmaxf(g[2], 1.f), fmaxf(g[3], 1.f)}; }
    static __device__ __forceinline__ f32x4 rcp4(f32x4 d) { f32x4 r; asm("v_rcp_f32_e32 %0, %1" : "=v"(r[0]) : "v"(d[0])); asm("v_rcp_f32_e32 %0, %1" : "=v"(r[1]) : "v"(d[1])); asm("v_rcp_f32_e32 %0, %1" : "=v"(r[2]) : "v"(d[2])); asm("v_rcp_f32_e32 %0, %1" : "=v"(r[3]) : "v"(d[3])); return r; }
    __device__ __forceinline__ void mid(f32x4 (&acc)[2][2][4][2], const Unit& u, int wr, int wc, int fr, int fq) const {
        const int row0 = u.pm * BM + wr * 64 + fr, gcol = (u.pn & 255) * BM + wc * 64 + 16 * fq;
        u32x4 gf[8], gm[8];
#pragma unroll
        for (int it = 0; it < 8; ++it) { const size_t o = (size_t)(row0 + (it >> 2) * HALF + (it & 3) * 16) * 1024 + gcol; gf[it] = *(const u32x4*)(Gf + o); gm[it] = *(const u32x4*)(Gm + o); }
#pragma unroll
        for (int it = 0; it < 8; ++it) { const int ai = it >> 2, m = it & 3;
#pragma unroll
            for (int bj = 0; bj < 2; ++bj) {
                acc[ai][bj][m][0] = acc[ai][bj][m][0] * (unpack_u8x4(bj ? gf[it].z : gf[it].x) * rcp4(den4(bj ? gm[it].z : gm[it].x)));
                acc[ai][bj][m][1] = acc[ai][bj][m][1] * (unpack_u8x4(bj ? gf[it].w : gf[it].y) * rcp4(den4(bj ? gm[it].w : gm[it].y))); } }
    }
    __device__ __forceinline__ void operator()(const f32x4 (&acc)[2][2][4][2], const Unit& u, int wr, int wc, int fr, int fq) const {
        const int row0 = u.pm * BM + wr * 64 + fr, pn = u.pn & 255, col0 = pn * BM + wc * 32 + 8 * fq, gcol = pn * BM + wc * 64 + 16 * fq;
        u32x4 gm[8];
#pragma unroll
        for (int it = 0; it < 8; ++it) gm[it] = *(const u32x4*)(Gm + (size_t)(row0 + (it >> 2) * HALF + (it & 3) * 16) * 1024 + gcol);
#pragma unroll
        for (int it = 0; it < 8; ++it) { const int ai = it >> 2, m = it & 3; const size_t roff = (size_t)(row0 + ai * HALF + m * 16) * 1024 + col0;
#pragma unroll
            for (int bj = 0; bj < 2; ++bj) { const f32x4 v0 = acc[ai][bj][m][0] * (den4(bj ? gm[it].z : gm[it].x) * (1.0f / 255.0f)), v1 = acc[ai][bj][m][1] * (den4(bj ? gm[it].w : gm[it].y) * (1.0f / 255.0f));
                u32x4 w; w.x = cvt_pk_bf16(v0[0], v0[1]); w.y = cvt_pk_bf16(v0[2], v0[3]); w.z = cvt_pk_bf16(v1[0], v1[1]); w.w = cvt_pk_bf16(v1[2], v1[3]);
                *(u32x4*)(T + roff + bj * HALF) = w; } }
    }
};

struct EpiXPre {
    static constexpr bool PERM = true, AFTER_DRAIN = false, STAGE = false; static constexpr bool CHAIN = false;
    unsigned char* WK8; unsigned char* VW8;
    __device__ __forceinline__ void operator()(const f32x4 (&acc)[2][2][4][2], const Unit& u, int wr, int wc, int fr, int fq) const {
        const int rloc = wr * 64 + fr;
        if (u.pm < 64) { const int row0 = u.pm * BM + rloc, gcol = u.pn * BM + wc * 64 + 16 * fq;
#pragma unroll
            for (int it = 0; it < 8; ++it) { const int ai = it >> 2, m = it & 3; u32x4 w;
#pragma unroll
                for (int bj = 0; bj < 2; ++bj) { const f32x4 v0 = acc[ai][bj][m][0] * WK8_SCALE, v1 = acc[ai][bj][m][1] * WK8_SCALE;
                    const unsigned lo = pk4f8(v0[0], v0[1], v0[2], v0[3]), hi = pk4f8(v1[0], v1[1], v1[2], v1[3]);
                    if (bj == 0) { w.x = lo; w.y = hi; } else { w.z = lo; w.w = hi; } }
                *(u32x4*)(WK8 + (size_t)(row0 + ai * HALF + m * 16) * 1024 + gcol) = w; }
        } else { const int row0 = (u.pm - 64) * BM + rloc, gcol = u.pn * BM + wc * 64 + 16 * fq;
#pragma unroll
            for (int it = 0; it < 8; ++it) { const int ai = it >> 2, m = it & 3; u32x4 w;
#pragma unroll
                for (int bj = 0; bj < 2; ++bj) { const f32x4 v0 = acc[ai][bj][m][0] * VW8_SCALE, v1 = acc[ai][bj][m][1] * VW8_SCALE;
                    const unsigned lo = pk4f8(v0[0], v0[1], v0[2], v0[3]), hi = pk4f8(v1[0], v1[1], v1[2], v1[3]);
                    if (bj == 0) { w.x = lo; w.y = hi; } else { w.z = lo; w.w = hi; } }
                *(u32x4*)(VW8 + (size_t)(row0 + ai * HALF + m * 16) * 1024 + gcol) = w; } }
    }
};

struct EpiMo8 {
    static constexpr bool PERM = true, AFTER_DRAIN = false, STAGE = true; static constexpr bool CHAIN = false;
    bf16_t* O; const float* ssp; PG8_LAS float* rsl; float wsc;
    __device__ __forceinline__ void stage(const Unit& u, int wid, int lane) const { rs_stage(ssp, rsl, u, wid, lane); }
    __device__ __forceinline__ void operator()(const f32x4 (&acc)[2][2][4][2], const Unit& u, int wr, int wc, int fr, int fq) const {
        float rsc[2][4]; rs_scale(rsc, rsl, wr, fr, fq);
        const int row0 = u.pm * BM + wr * 64 + fr, col0 = u.pn * BM + wc * 32 + 8 * fq;
#pragma unroll
        for (int ai = 0; ai < 2; ++ai)
#pragma unroll
            for (int m = 0; m < 4; ++m) { const float s = rsc[ai][m] * wsc; const size_t roff = (size_t)(row0 + ai * HALF + m * 16) * 512 + col0;
#pragma unroll
                for (int bj = 0; bj < 2; ++bj) { const f32x4 v0 = sigm4(acc[ai][bj][m][0] * s), v1 = sigm4(acc[ai][bj][m][1] * s);
                    u32x4 w; w.x = cvt_pk_bf16(v0[0], v0[1]); w.y = cvt_pk_bf16(v0[2], v0[3]); w.z = cvt_pk_bf16(v1[0], v1[1]); w.w = cvt_pk_bf16(v1[2], v1[3]);
                    *(u32x4*)(O + roff + bj * HALF) = w; } }
    }
};
typedef int v8i32_t __attribute__((ext_vector_type(8)));
typedef int v4i32_t __attribute__((ext_vector_type(4)));
__device__ __forceinline__ v8i32_t pg8_cat8(bf16x8 lo, bf16x8 hi) { const v4i32_t a = __builtin_bit_cast(v4i32_t, lo), b = __builtin_bit_cast(v4i32_t, hi); return __builtin_shufflevector(a, b, 0, 1, 2, 3, 4, 5, 6, 7); }
template <class Epi, class Sched, bool ALIGN_EPI = false, bool SP2 = false, bool F8 = false>
__device__ __forceinline__ void gemm_phase(PG8_LAS unsigned char* lds, const Gemm g, const Sched& S, const Epi& E) {
    int tid_ = threadIdx.x; asm volatile("" : "+v"(tid_));
    const int tid = tid_, wid = __builtin_amdgcn_readfirstlane(tid >> 6), lane = tid & 63, wr = wid >> 2, wc = wid & 3, fr = lane & 15, fq = lane >> 4;
    const int K = g.K, nt = K / BK;
    unsigned voffA[2], voffB[2];
#pragma unroll
    for (int i = 0; i < 2; ++i) { int R, C; stage_rc(tid * 16 + i * 8192, R, C); const int Rb = Epi::PERM ? ((R & ~31) + perm32(R & 31)) : R;
        voffA[i] = (unsigned)(R * g.lda + C) * 2u; voffB[i] = (unsigned)(Rb * g.ldb + C) * 2u; }
    const size_t kstep = (size_t)(BK * 2);
    const size_t hstepA = (size_t)HALF * g.lda * 2, hstepB = (size_t)HALF * g.ldb * 2;
    const unsigned ldsw = (unsigned)wid * 1024u;
    int aoff = lds_byte(wr * 64 + fr, fq * 8), boff = lds_byte(wc * 32 + fr, fq * 8);
#define PG8_SA(b, h) (((b) * 2 + (h)) * HTB)
#define PG8_SB(b, h) ((4 + (b) * 2 + (h)) * HTB)
#define PG8_STAGE(bufoff, gbase, voff) do { _Pragma("unroll") for (int _i = 0; _i < 2; ++_i) \
        __builtin_amdgcn_global_load_lds((const unsigned*)((const char*)(gbase) + (voff)[_i]), (PG8_LAS unsigned*)(lds + (bufoff) + ldsw + _i * 8192), 16, 0, 0); } while (0)
#define PG8_LDA(dst, b, h) do { if constexpr (F8) { _Pragma("unroll") for (int m = 0; m < 4; ++m) dst##_8[m] = pg8_cat8(*(const PG8_LAS bf16x8*)(lds + PG8_SA(b, h) + aoff + m * 2048), *(const PG8_LAS bf16x8*)(lds + PG8_SA(b, h) + aoff + m * 2048 + 1024)); } \
        else { _Pragma("unroll") for (int m = 0; m < 4; ++m) _Pragma("unroll") for (int k = 0; k < 2; ++k) dst[m][k] = *(const PG8_LAS bf16x8*)(lds + PG8_SA(b, h) + aoff + m * 2048 + k * 1024); } } while (0)
#define PG8_LDB(dst, b, h) do { if constexpr (F8) { _Pragma("unroll") for (int n = 0; n < 2; ++n) dst##_8[n] = pg8_cat8(*(const PG8_LAS bf16x8*)(lds + PG8_SB(b, h) + boff + n * 2048), *(const PG8_LAS bf16x8*)(lds + PG8_SB(b, h) + boff + n * 2048 + 1024)); } \
        else { _Pragma("unroll") for (int n = 0; n < 2; ++n) _Pragma("unroll") for (int k = 0; k < 2; ++k) dst[n][k] = *(const PG8_LAS bf16x8*)(lds + PG8_SB(b, h) + boff + n * 2048 + k * 1024); } } while (0)
#define PG8_MMA(ai, bj, At, Bt) do { __builtin_amdgcn_s_setprio(1); \
        if constexpr (F8) { _Pragma("unroll") for (int m = 0; m < 4; ++m) _Pragma("unroll") for (int n = 0; n < 2; ++n) \
            acc[ai][bj][m][n] = __builtin_amdgcn_mfma_scale_f32_16x16x128_f8f6f4(Bt##_8[n], At##_8[m], acc[ai][bj][m][n], 0, 0, 0, 0, 0, 0); }     \
        else { _Pragma("unroll") for (int m = 0; m < 4; ++m) _Pragma("unroll") for (int n = 0; n < 2; ++n) _Pragma("unroll") for (int k = 0; k < 2; ++k) \
            acc[ai][bj][m][n] = __builtin_amdgcn_mfma_f32_16x16x32_bf16(Bt[n][k], At[m][k], acc[ai][bj][m][n], 0, 0, 0); } \
        __builtin_amdgcn_s_setprio(0); } while (0)
#define PG8_WAIT_V(n) asm volatile("s_waitcnt vmcnt(" #n ")" ::: "memory")
#define PG8_WAIT_L(n) asm volatile("s_waitcnt lgkmcnt(" #n ")" ::: "memory")
#define PG8_BAR __builtin_amdgcn_s_barrier()
#define PG8_SCHED __builtin_amdgcn_sched_barrier(0)
    Unit cur, nxt; int ui = 0;
    if (!S.next(0, cur)) return;
    f32x4 acc[2][2][4][2];
#pragma unroll
    for (int a = 0; a < 2; ++a)
#pragma unroll
        for (int b = 0; b < 2; ++b)
#pragma unroll
            for (int m = 0; m < 4; ++m)
#pragma unroll
                for (int n = 0; n < 2; ++n) acc[a][b][m][n] = (f32x4){0.f, 0.f, 0.f, 0.f};
    bf16x8 At[4][2], B0[2][2], B1[2][2];
    v8i32_t At_8[4], B0_8[2], B1_8[2];
    const char* cA = S.abase(g, cur); const char* cB = S.bbase(g, cur);
    S.a_ready(cur);
    if constexpr (Epi::STAGE) { int t_s = threadIdx.x; asm volatile("" : "+v"(t_s)); E.stage(cur, wid, t_s & 63); }
    if constexpr (SP2) {
        PG8_STAGE(PG8_SB(0, 0), cB, voffB); PG8_STAGE(PG8_SB(0, 1), cB + hstepB, voffB); PG8_STAGE(PG8_SA(0, 0), cA, voffA); PG8_STAGE(PG8_SA(0, 1), cA + hstepA, voffA);
        if (wr == 1) PG8_BAR;
        PG8_WAIT_V(2); PG8_BAR;
        PG8_STAGE(PG8_SB(1, 0), cB + kstep, voffB); PG8_STAGE(PG8_SA(1, 0), cA + kstep, voffA); PG8_STAGE(PG8_SB(1, 1), cB + hstepB + kstep, voffB);
        PG8_WAIT_V(6); PG8_BAR;
    } else {
        PG8_STAGE(PG8_SB(0, 0), cB, voffB); PG8_STAGE(PG8_SA(0, 0), cA, voffA); PG8_STAGE(PG8_SB(0, 1), cB + hstepB, voffB); PG8_STAGE(PG8_SA(0, 1), cA + hstepA, voffA);
        if (wr == 1) PG8_BAR;
        PG8_WAIT_V(4); PG8_BAR;
        PG8_STAGE(PG8_SB(1, 0), cB + kstep, voffB); PG8_STAGE(PG8_SA(1, 0), cA + kstep, voffA); PG8_STAGE(PG8_SB(1, 1), cB + hstepB + kstep, voffB);
        PG8_WAIT_V(6); PG8_BAR;
    }
    for (;;) {
        const bool has_next = S.next(ui + 1, nxt);
        const char* nA = has_next ? S.abase(g, nxt) : cA; const char* nB = has_next ? S.bbase(g, nxt) : cB;
        for (int t = 0; t < nt; t += 2) {
            if constexpr (F8) asm volatile("" : "+v"(voffA[0]), "+v"(voffA[1]), "+v"(voffB[0]), "+v"(voffB[1]));
            const bool last = (t == nt - 2);
            const char* a1 = cA + (size_t)(t + 1) * kstep;
            const char* a2 = last ? nA : cA + (size_t)(t + 2) * kstep; const char* b2 = last ? nB : cB + (size_t)(t + 2) * kstep;
            const char* a3 = a2 + kstep; const char* b3 = b2 + kstep;
            if (last && has_next) S.a_ready(nxt);
            if constexpr (SP2) {
            PG8_LDB(B0, 0, 0); PG8_LDB(B1, 0, 1); PG8_SCHED; PG8_LDA(At, 0, 0); PG8_STAGE(PG8_SA(1, 1), a1 + hstepA, voffA);
            PG8_WAIT_V(8); PG8_WAIT_L(0); PG8_BAR; PG8_MMA(0, 0, At, B0); PG8_MMA(0, 1, At, B1); PG8_BAR; PG8_SCHED;
            PG8_LDA(At, 0, 1); PG8_STAGE(PG8_SB(0, 0), b2, voffB); PG8_STAGE(PG8_SB(0, 1), b2 + hstepB, voffB); PG8_STAGE(PG8_SA(0, 0), a2, voffA);
            PG8_WAIT_V(8); PG8_WAIT_L(0); PG8_BAR; PG8_MMA(1, 0, At, B0); PG8_MMA(1, 1, At, B1); PG8_BAR; PG8_SCHED;
            if constexpr (F8) asm volatile("" : "+v"(voffA[0]), "+v"(voffA[1]), "+v"(voffB[0]), "+v"(voffB[1]));
            PG8_LDB(B0, 1, 0); PG8_LDB(B1, 1, 1); PG8_SCHED; PG8_LDA(At, 1, 0); PG8_STAGE(PG8_SA(0, 1), a2 + hstepA, voffA);
            PG8_WAIT_V(8); PG8_WAIT_L(0); PG8_BAR; PG8_MMA(0, 0, At, B0); PG8_MMA(0, 1, At, B1); PG8_BAR; PG8_SCHED;
            PG8_LDA(At, 1, 1); PG8_STAGE(PG8_SB(1, 0), b3, voffB); PG8_STAGE(PG8_SB(1, 1), b3 + hstepB, voffB); PG8_STAGE(PG8_SA(1, 0), a3, voffA);
            PG8_WAIT_V(8); PG8_WAIT_L(0); PG8_BAR; PG8_MMA(1, 0, At, B0); PG8_MMA(1, 1, At, B1); PG8_BAR; PG8_SCHED;
            } else {
            PG8_LDB(B0, 0, 0); PG8_SCHED; PG8_LDA(At, 0, 0); PG8_STAGE(PG8_SA(1, 1), a1 + hstepA, voffA);
            PG8_WAIT_L(8); PG8_BAR; PG8_WAIT_L(0); PG8_MMA(0, 0, At, B0); PG8_BAR; PG8_SCHED;
            PG8_LDB(B1, 0, 1); PG8_STAGE(PG8_SB(0, 0), b2, voffB);
            PG8_BAR; PG8_WAIT_L(0); PG8_MMA(0, 1, At, B1); PG8_BAR;
            PG8_LDA(At, 0, 1); PG8_STAGE(PG8_SA(0, 0), a2, voffA);
            PG8_BAR; PG8_WAIT_L(0); PG8_MMA(1, 0, At, B0); PG8_BAR; PG8_SCHED;
            PG8_STAGE(PG8_SB(0, 1), b2 + hstepB, voffB);
            PG8_WAIT_V(6); PG8_BAR; PG8_MMA(1, 1, At, B1); PG8_BAR;
            PG8_LDB(B0, 1, 0); PG8_SCHED; PG8_LDA(At, 1, 0); PG8_STAGE(PG8_SA(0, 1), a2 + hstepA, voffA);
            PG8_WAIT_L(8); PG8_BAR; PG8_WAIT_L(0); PG8_MMA(0, 0, At, B0); PG8_BAR; PG8_SCHED;
            PG8_LDB(B1, 1, 1); PG8_STAGE(PG8_SB(1, 0), b3, voffB);
            PG8_BAR; PG8_WAIT_L(0); PG8_MMA(0, 1, At, B1); PG8_BAR;
            PG8_LDA(At, 1, 1); PG8_STAGE(PG8_SA(1, 0), a3, voffA);
            PG8_BAR; PG8_WAIT_L(0); PG8_MMA(1, 0, At, B0); PG8_BAR; PG8_SCHED;
            PG8_STAGE(PG8_SB(1, 1), b3 + hstepB, voffB);
            PG8_WAIT_V(6); PG8_BAR; PG8_MMA(1, 1, At, B1); PG8_BAR;
            }
        }
#if defined(PROBE_EPI)
        { volatile PG8_LAS unsigned* pm_ = (volatile PG8_LAS unsigned*)(lds + PROBE_MISC_OFF); if (tid == PROBE_EPI_TID && blockIdx.x == 0 && pm_[20]) { const unsigned long long t_ = __builtin_amdgcn_s_memrealtime(); pm_[22] = (unsigned)t_; pm_[23] = (unsigned)(t_ >> 32); } }
#endif
        if constexpr (ALIGN_EPI) { if (wr == 0) PG8_BAR; }
        if constexpr (!Epi::AFTER_DRAIN) { int t_e = threadIdx.x; asm volatile("" : "+v"(t_e));
            if constexpr (Epi::CHAIN) { if (cur.pn >> 8) E(acc, cur, wr, wc, t_e & 15, (t_e >> 4) & 3); else E.mid(acc, cur, wr, wc, t_e & 15, (t_e >> 4) & 3); }
            else E(acc, cur, wr, wc, t_e & 15, (t_e >> 4) & 3);
            S.done(cur); }
#if defined(PROBE_EPI)
        { volatile PG8_LAS unsigned* pm_ = (volatile PG8_LAS unsigned*)(lds + PROBE_MISC_OFF); if (tid == PROBE_EPI_TID && blockIdx.x == 0 && pm_[20]) { if (PROBE_EPI == 2) asm volatile("s_waitcnt vmcnt(0)" ::: "memory"); const unsigned long long d_ = __builtin_amdgcn_s_memrealtime() - ((unsigned long long)pm_[22] | ((unsigned long long)pm_[23] << 32)); pm_[16] = pm_[16] + (unsigned)d_; } }
#endif
        if (!has_next) break;
        if (!Epi::CHAIN || (cur.pn >> 8))
#pragma unroll
        for (int a = 0; a < 2; ++a)
#pragma unroll
            for (int b = 0; b < 2; ++b)
#pragma unroll
                for (int m = 0; m < 4; ++m)
#pragma unroll
                    for (int n = 0; n < 2; ++n) acc[a][b][m][n] = (f32x4){0.f, 0.f, 0.f, 0.f};
        cur = nxt; cA = nA; cB = nB; ++ui;
        if constexpr (Epi::STAGE) { PG8_WAIT_L(0); PG8_BAR; int t_s = threadIdx.x; asm volatile("" : "+v"(t_s)); E.stage(cur, wid, t_s & 63); }
        if constexpr (ALIGN_EPI) { if (wr == 1) PG8_BAR; }
    }
    PG8_WAIT_V(0);
    if constexpr (!ALIGN_EPI) { if (wr == 0) PG8_BAR; }
    PG8_BAR;
    if constexpr (Epi::AFTER_DRAIN) { E.fused(acc, cur, wr, wc, fr, fq, lds, wid, lane); S.done(cur); }
#undef PG8_SA
#undef PG8_SB
#undef PG8_STAGE
#undef PG8_LDA
#undef PG8_LDB
#undef PG8_MMA
#undef PG8_WAIT_V
#undef PG8_WAIT_L
#undef PG8_BAR
#undef PG8_SCHED
}
}
#include <hip/hip_bf16.h>
#include <cmath>
namespace attn_body {
using bf16=__hip_bfloat16;
using bf16x8=__attribute__((ext_vector_type(8)))short;
using s16x4=__attribute__((ext_vector_type(4)))short;
using f32x16=__attribute__((ext_vector_type(16)))float;
using u32x4=__attribute__((ext_vector_type(4)))unsigned;
using f32x4_t=__attribute__((ext_vector_type(4)))float;
constexpr int BATCH=16,NHEAD=8,SEQ=4096,D=64,DM=NHEAD*D;
constexpr int NW=8,QBLK=32,QB=QBLK*NW,KVBLK=64,NQB=SEQ/QB;
constexpr int ATTN_PITCH=DM, ATTN_UNIT_ROWS=QB;
__device__ __forceinline__ int crow(int r,int hi){return (r&3)+8*(r>>2)+4*hi;}
#define SBAR() __builtin_amdgcn_sched_barrier(0)
__device__ __forceinline__ void cmask(f32x16&p0,f32x16&p1,int jb,int qrel,int hi){
  const float NEG=-INFINITY; int kb=64*jb+4*hi;
  #pragma unroll
  for(int r=0;r<16;++r){int kv=kb+(r&3)+8*(r>>2); if(kv>qrel)p0[r]=NEG; if(kv+32>qrel)p1[r]=NEG;}
}

constexpr int NSLOT=3, SLOTB=8192;
constexpr int LDS_K=0, LDS_V=NSLOT*SLOTB, LDS_WS=2*NSLOT*SLOTB, LDS_OST=LDS_WS+NW*64*4, LDS_CB=LDS_OST+NW*4096, LDS_BYTES=LDS_CB+SEQ*4;
constexpr float C2=0.125f*1.4426950408889634f;
__device__ __forceinline__ void glds16(const void*gsrc,unsigned lds_dst){unsigned keep;
  asm volatile("s_mov_b32 %0, m0\n\ts_mov_b32 m0, %2\n\ts_nop 0\n\tglobal_load_lds_dwordx4 %1, off\n\ts_mov_b32 m0, %0":"=&s"(keep):"v"(gsrc),"s"(lds_dst):"memory");}
__device__ __forceinline__ float max3f(float a,float b,float c){float r;asm("v_max3_f32 %0, %1, %2, %3":"=v"(r):"v"(a),"v"(b),"v"(c));return r;}
__device__ __forceinline__ float max2f(float a,float b){float r;asm("v_max_f32_e32 %0, %1, %2":"=v"(r):"v"(a),"v"(b));return r;}
__device__ __forceinline__ float fadd_s(float a,float b){float r;asm("v_add_f32_e32 %0, %1, %2":"=v"(r):"v"(a),"v"(b));return r;}
__device__ __forceinline__ float fsub_s(float a,float b){float r;asm("v_sub_f32_e32 %0, %1, %2":"=v"(r):"v"(a),"v"(b));return r;}
typedef float f32x2_t __attribute__((ext_vector_type(2))); typedef __bf16 bf16x2_t __attribute__((ext_vector_type(2)));
__device__ __forceinline__ unsigned cvtpk_s(float lo,float hi){f32x2_t v={lo,hi};bf16x2_t b=__builtin_convertvector(v,bf16x2_t);return __builtin_bit_cast(unsigned,b);}
#define WAIT_BAR(N) asm volatile("s_waitcnt vmcnt(" #N ") lgkmcnt(0)\n\ts_barrier":::"memory")

__device__ __forceinline__ void qkt(f32x16&p0,f32x16&p1,const char*Kslot,const bf16x8*qr,int r32,int hi){
  const char*kb=Kslot+hi*1024+r32*16;
  #pragma unroll
  for(int d0=0;d0<4;++d0){
    const bf16x8 b0=*reinterpret_cast<const bf16x8*>(kb+d0*2048);
    const bf16x8 b1=*reinterpret_cast<const bf16x8*>(kb+d0*2048+512);
    p0=__builtin_amdgcn_mfma_f32_32x32x16_bf16(b0,qr[d0],p0,0,0,0);p1=__builtin_amdgcn_mfma_f32_32x32x16_bf16(b1,qr[d0],p1,0,0,0);}
}
typedef __attribute__((address_space(3))) const char* lds_cptr;
typedef short v4i16_t __attribute__((ext_vector_type(4)));
__device__ __forceinline__ void kload8(bf16x8*kf,lds_cptr kp){
  kf[0]=*(const __attribute__((address_space(3))) bf16x8*)(kp);      kf[1]=*(const __attribute__((address_space(3))) bf16x8*)(kp+512);
  kf[2]=*(const __attribute__((address_space(3))) bf16x8*)(kp+2048); kf[3]=*(const __attribute__((address_space(3))) bf16x8*)(kp+2560);
  kf[4]=*(const __attribute__((address_space(3))) bf16x8*)(kp+4096); kf[5]=*(const __attribute__((address_space(3))) bf16x8*)(kp+4608);
  kf[6]=*(const __attribute__((address_space(3))) bf16x8*)(kp+6144); kf[7]=*(const __attribute__((address_space(3))) bf16x8*)(kp+6656);
}
__device__ __forceinline__ void kload2(bf16x8*kf,lds_cptr kp,int j){ kf[2*j]=*(const __attribute__((address_space(3))) bf16x8*)(kp+j*2048); kf[2*j+1]=*(const __attribute__((address_space(3))) bf16x8*)(kp+j*2048+512); }
__device__ __forceinline__ s16x4 vtr(lds_cptr p){ return __builtin_bit_cast(s16x4,__builtin_amdgcn_ds_read_tr16_b64_v4i16((__attribute__((address_space(3))) v4i16_t*)p)); }
__device__ __forceinline__ float rowmax(const f32x16&p0,const f32x16&p1){
  float a=max3f(p0[0],p0[1],p1[0]),b=max3f(p0[2],p0[3],p1[1]);a=max3f(a,p1[2],p1[3]);
  #pragma unroll
  for(int r=4;r<16;r+=4){a=max3f(a,p0[r],p0[r+1]);b=max3f(b,p0[r+2],p0[r+3]);a=max3f(a,p1[r],p1[r+1]);b=max3f(b,p1[r+2],p1[r+3]);}
  const float m=max2f(a,b);
  auto rr=__builtin_amdgcn_permlane32_swap(__float_as_uint(m),__float_as_uint(m),false,false);
  return max2f(__uint_as_float(rr[0]),__uint_as_float(rr[1]));
}
__device__ __forceinline__ void pv(f32x16*o,int vb,bf16x8 pa0,bf16x8 pa1,bf16x8 pa2,bf16x8 pa3){
  #pragma unroll
  for(int d0=0;d0<2;++d0){s16x4 lo[4],hi[4];
    #pragma unroll
    for(int ks=0;ks<4;++ks){
      asm volatile("ds_read_b64_tr_b16 %0,%1 offset:%c2":"=&v"(lo[ks]):"v"(vb),"i"(d0*4096+ks*1024):"memory");
      asm volatile("ds_read_b64_tr_b16 %0,%1 offset:%c2":"=&v"(hi[ks]):"v"(vb),"i"(d0*4096+ks*1024+512):"memory");}
    asm volatile("s_waitcnt lgkmcnt(0)":::"memory");SBAR();
    #define PK(k) (bf16x8){lo[k][0],lo[k][1],lo[k][2],lo[k][3],hi[k][0],hi[k][1],hi[k][2],hi[k][3]}
    o[d0]=__builtin_amdgcn_mfma_f32_32x32x16_bf16(pa0,PK(0),o[d0],0,0,0);
    o[d0]=__builtin_amdgcn_mfma_f32_32x32x16_bf16(pa1,PK(1),o[d0],0,0,0);
    o[d0]=__builtin_amdgcn_mfma_f32_32x32x16_bf16(pa2,PK(2),o[d0],0,0,0);
    o[d0]=__builtin_amdgcn_mfma_f32_32x32x16_bf16(pa3,PK(3),o[d0],0,0,0);
    #undef PK
  }
}

#ifndef ATTN_STORE16
#define ATTN_STORE16(p,v) (*(u32x4*)(p)=(v))
#endif
template<int THRL> __device__ __forceinline__ void attn_unit(int b,int h,int qb,const bf16*Q,const bf16*__restrict__ K,const bf16*__restrict__ V,bf16*O,char*shm,const float*CBg=nullptr){
  int tid_=threadIdx.x; asm volatile("":"+v"(tid_));
  const int tid=tid_,lane=tid&63,r32=lane&31,hi=lane>>5; const int wid=__builtin_amdgcn_readfirstlane(tid>>6);
  const long rowbase=(long)b*SEQ; const int q0=qb*QB;
  const bf16*Qw=Q+(rowbase+q0+wid*QBLK)*DM+h*D;
  const bf16*Kh=K+rowbase*DM+h*D,*Vh=V+rowbase*DM+h*D;
  const unsigned lds0=(unsigned)(uintptr_t)shm;
  float*wsf=(float*)(shm+LDS_WS)+wid*64;
  const bf16*ksrc=Kh+(long)lane*DM+wid*8;
  const bf16*vsrc=Vh+(long)(16*(wid&3)+(lane>>2))*DM+(wid>>2)*32+(lane&3)*8;
  const unsigned kdst=lds0+LDS_K+wid*1024, vdst=lds0+LDS_V+wid*1024;
  #define DMA_K(t,slot) glds16(ksrc+(long)(t)*KVBLK*DM,(unsigned)__builtin_amdgcn_readfirstlane(kdst+(slot)))
  #define DMA_V(t,slot) glds16(vsrc+(long)(t)*KVBLK*DM,(unsigned)__builtin_amdgcn_readfirstlane(vdst+(slot)))
  const int vb0=(int)(lds0+LDS_V)+((lane>>4)&1)*32+(lane&3)*8+(4*hi+((lane&15)>>2))*64;
  const char*Kbase=shm+LDS_K; bf16x8 kf[8];
  const lds_cptr shm3=(lds_cptr)shm; const lds_cptr kp0=shm3+LDS_K+hi*1024+r32*16; const lds_cptr vp0=shm3+LDS_V+((lane>>4)&1)*32+(lane&3)*8+(4*hi+((lane&15)>>2))*64;
  const int NT=(q0+QB)/KVBLK;
  DMA_K(0,0);DMA_V(0,0);DMA_K(1,SLOTB);
  bf16x8 qr[4];
  #pragma unroll
  for(int d0=0;d0<4;++d0)qr[d0]=*reinterpret_cast<const bf16x8*>(&Qw[(long)r32*DM+d0*16+hi*8]);
  float l_reg=0.f;f32x16 o[2];o[0]=f32x16{};o[1]=f32x16{};
  typedef __attribute__((address_space(3))) const float* lds_fptr; const lds_fptr cbt=(lds_fptr)(shm3+LDS_CB)+4*hi;
  float negcq;
  #define CBINIT(P0,P1,tt) do{ _Pragma("unroll") for(int g_=0;g_<4;++g_){ const f32x4_t a_=*(const __attribute__((address_space(3))) f32x4_t*)(cbt+64*(tt)+8*g_), b_=*(const __attribute__((address_space(3))) f32x4_t*)(cbt+64*(tt)+32+8*g_); \
      P0[4*g_]=a_[0]+negcq;P0[4*g_+1]=a_[1]+negcq;P0[4*g_+2]=a_[2]+negcq;P0[4*g_+3]=a_[3]+negcq; P1[4*g_]=b_[0]+negcq;P1[4*g_+1]=b_[1]+negcq;P1[4*g_+2]=b_[2]+negcq;P1[4*g_+3]=b_[3]+negcq; } }while(0)
  const int qrel=wid*QBLK+r32;
  #define CMASK(P0,P1,t) do{int jb_=(t)-(NT-4); if(jb_>=0)cmask(P0,P1,jb_,qrel,hi);}while(0)
  bool resc=false;
  #define START(P0,P1) do{ const float rm=rowmax(P0,P1); resc=false; \
    { const float dl=__builtin_fmaxf(rm,0.f); negcq=fsub_s(negcq,dl);     \
      _Pragma("unroll") for(int r=0;r<16;++r){P0[r]=fsub_s(P0[r],dl);P1[r]=fsub_s(P1[r],dl);} } \
    _Pragma("unroll") for(int r=0;r<16;++r)P0[r]=__builtin_amdgcn_exp2f(P0[r]); }while(0)
  #define RESC() do{ if(resc){ asm volatile("s_waitcnt lgkmcnt(0)":::"memory"); \
      _Pragma("unroll") for(int d_=0;d_<2;++d_) _Pragma("unroll") for(int r=0;r<16;++r)o[d_][r]*=wsf[crow(r,hi)]; } }while(0)
  f32x16 pA0,pA1,pB0,pB1;
  int sl_prev=0,sl_cur=0,sl_next=SLOTB;
  #define ROT() do{sl_prev=sl_cur;sl_cur=sl_next;sl_next=(sl_next==(NSLOT-1)*SLOTB)?0:sl_next+SLOTB;}while(0)
  DMA_K(2,2*SLOTB);
  if(CBg){ const f32x4_t*src=reinterpret_cast<const f32x4_t*>(CBg); f32x4_t*dst=reinterpret_cast<f32x4_t*>(shm+LDS_CB);
    #pragma unroll
    for(int k=0;k<SEQ/4/512;++k){ const int i_=tid+512*k; if(i_<NT*16)dst[i_]=src[i_]; } }
  WAIT_BAR(3);
  negcq=-((lds_fptr)(shm3+LDS_CB))[q0+wid*QBLK+r32];
  CBINIT(pA0,pA1,0);
  qkt(pA0,pA1,Kbase,qr,r32,hi);asm volatile("s_nop 15\n\ts_nop 7":"+v"(pA0),"+v"(pA1));CMASK(pA0,pA1,0);
  START(pA0,pA1);
  CBINIT(pB0,pB1,1);
  _Pragma("unroll") for(int r=0;r<16;++r)pA1[r]=__builtin_amdgcn_exp2f(pA1[r]);
  WAIT_BAR(0);
  DMA_K(3,0);DMA_V(1,SLOTB);
  ROT();
  kload8(kf,kp0+sl_cur);
  WAIT_BAR(2);
  s16x4 vlo[8],vhi[8]; u32x4 pw0,pw1,pw2,pw3;
  #define PKW(P,B) cvtpk_s(P[B],P[B+1])
  #define PAF(k) __builtin_bit_cast(bf16x8,pw##k)
  #define VFR(i) (bf16x8){vlo[i][0],vlo[i][1],vlo[i][2],vlo[i][3],vhi[i][0],vhi[i][1],vhi[i][2],vhi[i][3]}
  #define PIN(x) asm volatile("":"+v"(x))
  #define MX3(a,b,c) __builtin_fmaxf(__builtin_fmaxf((a),(b)),(c))
  #define GAPA(MF,A0,A1,A2,A3,W0,W1,PW) do{ MF; sacc+=A0; sacc+=A1; sacc+=A2; sacc+=A3; PIN(sacc); W0; W1; PIN(PW); SBAR(); }while(0)
  #define EX(v) __builtin_amdgcn_exp2f(v)
  #define GAPB(MF,X,B,G,Y,YB) do{ MF; X[B]=EX(X[B]); X[B+1]=EX(X[B+1]); X[B+2]=EX(X[B+2]); X[B+3]=EX(X[B+3]); PIN(X); if(G){ Y[YB]+=negcq; Y[YB+1]+=negcq; Y[YB+2]+=negcq; Y[YB+3]+=negcq; PIN(Y); } SBAR(); }while(0)
  #define CBLD(P0,P1,tt) do{ _Pragma("unroll") for(int g_=0;g_<4;++g_){ const f32x4_t a_=*(const __attribute__((address_space(3))) f32x4_t*)(cbt+64*(tt)+8*g_), b_=*(const __attribute__((address_space(3))) f32x4_t*)(cbt+64*(tt)+32+8*g_); \
      P0[4*g_]=a_[0];P0[4*g_+1]=a_[1];P0[4*g_+2]=a_[2];P0[4*g_+3]=a_[3]; P1[4*g_]=b_[0];P1[4*g_+1]=b_[1];P1[4*g_+2]=b_[2];P1[4*g_+3]=b_[3]; } }while(0)
  #define VRD(i) do{ vlo[i]=vtr(vp_+(((i)>>2)*4096+((i)&3)*1024)); vhi[i]=vtr(vp_+(((i)>>2)*4096+((i)&3)*1024+512)); }while(0)
  #define KRD(G,j) do{ if(G){ kload2(kf,kp0+sl_next,j); SBAR(); } }while(0)
  #define STEP(C0,C1,P0,P1,t,GK,GV,GL) do{ SBAR(); \
    const lds_cptr vp_=vp0+sl_prev; \
    VRD(0); SBAR(); float sacc=(P0[0]+P0[1]); \
    GAPA(C0=__builtin_amdgcn_mfma_f32_32x32x16_bf16(kf[0],qr[0],C0,0,0,0), P0[2],P0[3],P0[4],P0[5],     pw0[0]=PKW(P0,0), pw0[1]=PKW(P0,2), pw0); \
    VRD(4); SBAR(); GAPA(C1=__builtin_amdgcn_mfma_f32_32x32x16_bf16(kf[1],qr[0],C1,0,0,0), P0[6],P0[7],P0[8],P0[9],     pw0[2]=PKW(P0,4), pw0[3]=PKW(P0,6), pw0); \
    VRD(1); SBAR(); GAPA(C0=__builtin_amdgcn_mfma_f32_32x32x16_bf16(kf[2],qr[1],C0,0,0,0),   P0[10],P0[11],P0[12],P0[13], pw1[0]=PKW(P0,8), pw1[1]=PKW(P0,10), pw1); \
    VRD(5); SBAR(); GAPA(C1=__builtin_amdgcn_mfma_f32_32x32x16_bf16(kf[3],qr[1],C1,0,0,0),   P0[14],P0[15],P1[0],P1[1],   pw1[2]=PKW(P0,12),pw1[3]=PKW(P0,14), pw1); \
    VRD(2); SBAR(); GAPA(C0=__builtin_amdgcn_mfma_f32_32x32x16_bf16(kf[4],qr[2],C0,0,0,0),   P1[2],P1[3],P1[4],P1[5],     pw2[0]=PKW(P1,0), pw2[1]=PKW(P1,2), pw2); \
    VRD(6); SBAR(); GAPA(C1=__builtin_amdgcn_mfma_f32_32x32x16_bf16(kf[5],qr[2],C1,0,0,0),   P1[6],P1[7],P1[8],P1[9],     pw2[2]=PKW(P1,4), pw2[3]=PKW(P1,6), pw2); \
    VRD(3); SBAR(); GAPA(C0=__builtin_amdgcn_mfma_f32_32x32x16_bf16(kf[6],qr[3],C0,0,0,0),   P1[10],P1[11],P1[12],P1[13], pw3[0]=PKW(P1,8), pw3[1]=PKW(P1,10), pw3); \
    VRD(7); SBAR(); GAPA(C1=__builtin_amdgcn_mfma_f32_32x32x16_bf16(kf[7],qr[3],C1,0,0,0),   P1[14],P1[15],0.f,0.f,       pw3[2]=PKW(P1,12),pw3[3]=PKW(P1,14), pw3); \
    l_reg+=sacc; \
    if(GK){DMA_K((t)+3,sl_cur);} if(GV){DMA_V((t)+1,sl_next);} \
    CMASK(C0,C1,t); \
    { float a=MX3(C0[0],C0[1],C1[0]),b=MX3(C0[2],C0[3],C1[1]); a=MX3(a,C1[2],C1[3]); \
      _Pragma("unroll") for(int r=4;r<16;r+=4){a=MX3(a,C0[r],C0[r+1]);b=MX3(b,C0[r+2],C0[r+3]);a=MX3(a,C1[r],C1[r+1]);b=MX3(b,C1[r+2],C1[r+3]);} \
      float rm=__builtin_fmaxf(a,b); { auto rr=__builtin_amdgcn_permlane32_swap(__float_as_uint(rm),__float_as_uint(rm),false,false); rm=__builtin_fmaxf(__uint_as_float(rr[0]),__uint_as_float(rr[1])); } \
      resc=false; \
      if(__builtin_expect(__any(rm>(float)THRL),0)){ const float dl=__builtin_fmaxf(rm,0.f); negcq-=dl; \
        _Pragma("unroll") for(int r=0;r<16;++r){C0[r]-=dl;C1[r]-=dl;} \
        const float f=__builtin_amdgcn_exp2f(-dl); l_reg*=f; if(hi==0)wsf[r32]=f; resc=true; } } \
    SBAR(); \
    if(GL){ CBLD(P0,P1,(t)+1); SBAR(); }     \
    GAPB(o[0]=__builtin_amdgcn_mfma_f32_32x32x16_bf16(PAF(0),VFR(0),o[0],0,0,0), C0,0, GL,P0,0); \
    GAPB(o[1]=__builtin_amdgcn_mfma_f32_32x32x16_bf16(PAF(0),VFR(4),o[1],0,0,0), C0,4, GL,P0,4); \
    KRD(GL,0); GAPB(o[0]=__builtin_amdgcn_mfma_f32_32x32x16_bf16(PAF(1),VFR(1),o[0],0,0,0), C0,8, GL,P0,8); \
    KRD(GL,1); GAPB(o[1]=__builtin_amdgcn_mfma_f32_32x32x16_bf16(PAF(1),VFR(5),o[1],0,0,0), C0,12, GL,P0,12); \
    KRD(GL,2); GAPB(o[0]=__builtin_amdgcn_mfma_f32_32x32x16_bf16(PAF(2),VFR(2),o[0],0,0,0), C1,0, GL,P1,0); \
    KRD(GL,3); GAPB(o[1]=__builtin_amdgcn_mfma_f32_32x32x16_bf16(PAF(2),VFR(6),o[1],0,0,0), C1,4, GL,P1,4); \
    GAPB(o[0]=__builtin_amdgcn_mfma_f32_32x32x16_bf16(PAF(3),VFR(3),o[0],0,0,0), C1,8, GL,P1,8); \
    GAPB(o[1]=__builtin_amdgcn_mfma_f32_32x32x16_bf16(PAF(3),VFR(7),o[1],0,0,0), C1,12, GL,P1,12); \
    }while(0)
  int t=1;
  #undef CMASK
  #define CMASK(P0,P1,t) do{}while(0)
  for(;t+5<NT;t+=2){
    STEP(pB0,pB1,pA0,pA1,t,true,true,true);     WAIT_BAR(2); RESC(); ROT();
    STEP(pA0,pA1,pB0,pB1,t+1,true,true,true);   WAIT_BAR(2); RESC(); ROT();
  }
  #undef CMASK
  #define CMASK(P0,P1,t) do{int jb_=(t)-(NT-4); if(jb_>=0)cmask(P0,P1,jb_,qrel,hi);}while(0)
  #define ENDW(tt) do{ if((tt)+3<NT){WAIT_BAR(2);} else if((tt)+2<NT){WAIT_BAR(1);} else {WAIT_BAR(0);} }while(0)
  for(;t+1<NT;t+=2){
    STEP(pB0,pB1,pA0,pA1,t,(t+3<NT),(t+1<NT),(t+1<NT));       ENDW(t);   RESC(); ROT();
    STEP(pA0,pA1,pB0,pB1,t+1,(t+4<NT),(t+2<NT),(t+2<NT));     ENDW(t+1); RESC(); ROT();
  }
  STEP(pB0,pB1,pA0,pA1,NT-1,false,false,false); RESC();
  { float sacc=pB0[0]+pB0[1]; _Pragma("unroll") for(int r=2;r<16;++r)sacc+=pB0[r]; _Pragma("unroll") for(int r=0;r<16;++r)sacc+=pB1[r]; l_reg+=sacc;
    pw0=(u32x4){PKW(pB0,0),PKW(pB0,2),PKW(pB0,4),PKW(pB0,6)};pw1=(u32x4){PKW(pB0,8),PKW(pB0,10),PKW(pB0,12),PKW(pB0,14)};pw2=(u32x4){PKW(pB1,0),PKW(pB1,2),PKW(pB1,4),PKW(pB1,6)};pw3=(u32x4){PKW(pB1,8),PKW(pB1,10),PKW(pB1,12),PKW(pB1,14)};
    SBAR(); pv(o,vb0+sl_cur,PAF(0),PAF(1),PAF(2),PAF(3)); }
  #undef PKW
  #undef PAF
  #undef VFR
  #undef PIN
  #undef MX3
  #undef GAPA
  #undef GAPB
  #undef EX
  #undef VRD
  #undef KRD
  #undef STEP
  #undef ENDW
  {auto rr=__builtin_amdgcn_permlane32_swap(__float_as_uint(l_reg),__float_as_uint(l_reg),false,false);l_reg=__uint_as_float(rr[0])+__uint_as_float(rr[1]);}
  if(hi==0)wsf[32+r32]=l_reg;asm volatile("s_waitcnt lgkmcnt(0)":::"memory");
  float rli[16];
  #pragma unroll
  for(int r=0;r<16;++r)rli[r]=__builtin_amdgcn_rcpf(wsf[32+crow(r,hi)]);
  bf16*Ow=O+(rowbase+q0+wid*QBLK)*DM+h*D;
  { bf16*stg=(bf16*)(shm+LDS_OST)+wid*2048;
    #pragma unroll
    for(int r=0;r<16;++r){const int orow=crow(r,hi);
      #pragma unroll
      for(int d0=0;d0<2;++d0)stg[orow*64+d0*32+r32]=__float2bfloat16(o[d0][r]*rli[r]);}
    asm volatile("s_waitcnt lgkmcnt(0)":::"memory");
    #pragma unroll
    for(int i=0;i<4;++i){const int row=i*8+(lane>>3),ch=lane&7; const u32x4 v=*(const u32x4*)(stg+row*64+ch*8); ATTN_STORE16(Ow+(long)row*DM+ch*8,v);} }
  asm volatile("s_waitcnt lgkmcnt(0)\n\ts_barrier":::"memory");
  #undef DMA_K
  #undef DMA_V
  #undef CMASK
  #undef START
  #undef RESC
  #undef ROT
  #undef CBINIT
  #undef CBLD
}
constexpr int ATTN_LDS_BYTES=LDS_BYTES;
struct AttnTensors { const bf16* Q; const bf16* K; const bf16* V; bf16* O; };
struct AttnUnit { int bh; int qb; };
template<int THRL=8> __device__ __forceinline__ void attn_queue(char*lds,const AttnTensors&T,const float*CB,unsigned*ctr,volatile __attribute__((address_space(3))) unsigned*slot){
  int t_=threadIdx.x; asm volatile("":"+v"(t_));
  const unsigned x0=((unsigned)__builtin_amdgcn_s_getreg((3<<11)|20))&7u;
  constexpr unsigned PERQ=(unsigned)(BATCH*NHEAD*NQB/8);
  for(unsigned j=0;j<8u;++j){ const unsigned x=(x0+j)&7u;
    if(t_==0)*slot=__hip_atomic_fetch_add(ctr+64*x,1u,__ATOMIC_RELAXED,__HIP_MEMORY_SCOPE_AGENT);
    __syncthreads();
    unsigned q=(unsigned)__builtin_amdgcn_readfirstlane((int)*slot);
    while(q<PERQ){
      unsigned nq=0u; if(t_==0)nq=__hip_atomic_fetch_add(ctr+64*x,1u,__ATOMIC_RELAXED,__HIP_MEMORY_SCOPE_AGENT);
#if defined(FOX_ORDER_BH)
      const int qb=NQB-1-(int)(q&15u),bh=(int)(x*16u+(q>>4));
#else
      const int qb=NQB-1-(int)(q>>4),bh=(int)(x*16u+(q&15u));
#endif
      attn_unit<THRL>(bh/NHEAD,bh%NHEAD,qb,T.Q,T.K,T.V,T.O,lds,CB+(long)bh*SEQ);
      if(t_==0)*slot=nq;
      __syncthreads();
      q=(unsigned)__builtin_amdgcn_readfirstlane((int)*slot);
    }
    __syncthreads();
  }
}
#undef SBAR
#undef WAIT_BAR
}
#define GAS __attribute__((address_space(1)))
#define LAS __attribute__((address_space(3)))
typedef unsigned short bf16;
typedef unsigned v4u __attribute__((ext_vector_type(4)));
typedef float f32x4 __attribute__((ext_vector_type(4)));
typedef short bf16x8 __attribute__((ext_vector_type(8)));
typedef GAS unsigned gu32;
typedef GAS unsigned long long gu64;
#define RLX_AGENT __ATOMIC_RELAXED, __HIP_MEMORY_SCOPE_AGENT
#define LDS_WAIT() asm volatile("s_waitcnt lgkmcnt(0)" ::: "memory")
#define VM_WAIT() asm volatile("s_waitcnt vmcnt(0)" ::: "memory")
__device__ __forceinline__ unsigned long long rt() { return __builtin_amdgcn_s_memrealtime(); }
__device__ __forceinline__ unsigned f2bf(float f) { unsigned u = __builtin_bit_cast(unsigned, f); return (u + 0x7fffu + ((u >> 16) & 1u)) >> 16; }
__device__ __forceinline__ unsigned pk2(float lo, float hi) { return f2bf(lo) | (f2bf(hi) << 16); }
#define XB_TMO      128
#define XB_XCNT(j)  (256  + 64 * (j))
#define XB_XSUB(j)  (1280 + 64 * (j))
#define XB_XGEN(j)  (2304 + 64 * (j))
#define XB_TOP      3328
#define XB_TOPGEN   3392
#define XCD_BAR_WORDS 3456
#define XB_SPIN_CAP (1u << 18)

__device__ __forceinline__ unsigned xb_ld(unsigned* p)              { return __hip_atomic_load(p, __ATOMIC_RELAXED, __HIP_MEMORY_SCOPE_AGENT); }
__device__ __forceinline__ unsigned xb_add(unsigned* p, unsigned v) { return __hip_atomic_fetch_add(p, v, __ATOMIC_RELAXED, __HIP_MEMORY_SCOPE_AGENT); }
__device__ __forceinline__ unsigned xb_xcc_id() { return (unsigned)__builtin_amdgcn_s_getreg((3 << 11) | 20) & 0xFu; }
#define XB_SPIN(cond, bar) do { unsigned _sp = 0; while (cond) { __builtin_amdgcn_s_sleep(1); \
    if ((++_sp & 255u) == 0u) { if (xb_ld(&(bar)[XB_TMO])) break; if (_sp > XB_SPIN_CAP) { atomicAdd(&(bar)[XB_TMO], 1u); break; } } } } while (0)

struct XcdBarrier {
    unsigned* bar; unsigned x;
    volatile LAS unsigned* st;
};

__device__ __forceinline__ XcdBarrier xcd_barrier_post(unsigned* bar, volatile LAS unsigned* st) {
    XcdBarrier b; b.bar = bar; b.x = xb_xcc_id(); b.st = st;
    if (threadIdx.x == 0) st[3] = xb_add(&bar[XB_XCNT(b.x)], 1u);
    return b;
}
__device__ __forceinline__ void xcd_barrier_complete(unsigned* bar, unsigned x, unsigned& nloc, unsigned& nx) {
    const unsigned G = gridDim.x * gridDim.y * gridDim.z;
    unsigned sum, cnt, mine, sp = 0u;
    for (;;) {
        sum = 0u; cnt = 0u; mine = 0u;
#pragma unroll
        for (unsigned j = 0; j < 16; ++j) { const unsigned c = xb_ld(&bar[XB_XCNT(j)]); sum += c; cnt += (c > 0u) ? 1u : 0u; mine = (j == x) ? c : mine; }
        if (sum == G) break;
        __builtin_amdgcn_s_sleep(1);
        if ((++sp & 255u) == 0u) { if (xb_ld(&bar[XB_TMO])) break; if (sp > XB_SPIN_CAP) { atomicAdd(&bar[XB_TMO], 1u); break; } }
    }
    nloc = mine > 0u ? mine : 1u; nx = cnt > 0u ? cnt : 1u;
}
__device__ __forceinline__ unsigned xcd_census_even(unsigned* bar) {
    const unsigned G = gridDim.x * gridDim.y * gridDim.z; unsigned ok = (G % 8u == 0u) ? 1u : 0u;
#pragma unroll
    for (unsigned j = 0; j < 16; ++j) { const unsigned c = xb_ld(&bar[XB_XCNT(j)]); if (c != (j < 8u ? G / 8u : 0u)) ok = 0u; }
    return ok;
}

__device__ __forceinline__ void xcd_barrier(const XcdBarrier& b) {
    asm volatile("s_waitcnt vmcnt(0)" ::: "memory");
    __syncthreads();
    if (threadIdx.x == 0) {
        unsigned* bar = b.bar;
        __builtin_amdgcn_s_waitcnt(0);
        unsigned nloc = b.st[0], nx = b.st[1];
        if (nloc == 0u) { xcd_barrier_complete(bar, b.x, nloc, nx); b.st[0] = nloc; b.st[1] = nx; b.st[2] = xcd_census_even(bar); }
        const unsigned old = xb_add(&bar[XB_XSUB(b.x)], 1u);
        const unsigned gen = old / nloc;
        if (old + 1u == (gen + 1u) * nloc) {
            __builtin_amdgcn_fence(__ATOMIC_RELEASE, "agent");
            asm volatile("s_waitcnt vmcnt(0)" ::: "memory");
            const unsigned og = xb_add(&bar[XB_TOP], 1u);
            const unsigned tg = og / nx;
            if (og + 1u == (tg + 1u) * nx) xb_add(&bar[XB_TOPGEN], 1u);
            else XB_SPIN(xb_ld(&bar[XB_TOPGEN]) == tg, bar);
            __builtin_amdgcn_fence(__ATOMIC_ACQUIRE, "agent");
            xb_add(&bar[XB_XGEN(b.x)], 1u);
            asm volatile("s_waitcnt vmcnt(0)" ::: "memory");
        } else {
            XB_SPIN(xb_ld(&bar[XB_XGEN(b.x)]) == gen, bar);
            __builtin_amdgcn_fence(__ATOMIC_ACQUIRE, "agent");
            asm volatile("s_waitcnt vmcnt(0)" ::: "memory");
        }
    }
    __syncthreads();
}

__device__ __forceinline__ void xcd_barrier_local(const XcdBarrier& b) {
    asm volatile("s_waitcnt vmcnt(0)" ::: "memory");
    __syncthreads();
    if (threadIdx.x == 0) {
        unsigned* bar = b.bar;
        __builtin_amdgcn_s_waitcnt(0);
        const unsigned nloc = b.st[0];
        const unsigned old = xb_add(&bar[XB_XSUB(b.x)], 1u);
        const unsigned gen = old / nloc;
        if (old + 1u == (gen + 1u) * nloc) xb_add(&bar[XB_XGEN(b.x)], 1u);
        else XB_SPIN(xb_ld(&bar[XB_XGEN(b.x)]) == gen, bar);
        __builtin_amdgcn_fence(__ATOMIC_ACQUIRE, "agent");
        asm volatile("s_waitcnt vmcnt(0)" ::: "memory");
    }
    __syncthreads();
}
constexpr int NWAVES = 8;
constexpr int DM = 1024, NB = 16, SEQ = 4096, DEPTH = 4, M = NB * SEQ;
constexpr int NMEM = 256, MROWS = NB * NMEM;
constexpr int DFF = 4096, INW = 5648;
constexpr float EPS = 1e-6f, LOG2E = 1.4426950408889634f;
constexpr float FOX_QS = 0.125f * LOG2E;
constexpr float X_QS = 0.0625f * LOG2E;
constexpr float GATE_WS = 64.f;
constexpr float ML_KS = 0.08838834764831845f;

constexpr size_t MiB = 1u << 20;
constexpr size_t WS_CTL = 0, CTL_ZERO_BYTES = 64 * 1024;
constexpr size_t WS_FFL = 1 * MiB;
constexpr size_t WS_IG = 3 * MiB;
constexpr size_t WS_LF = 4 * MiB;
constexpr size_t WS_CN2 = 5 * MiB;
constexpr size_t WS_MG = 8 * MiB;
constexpr size_t WS_W = 16 * MiB, WL = 36 * MiB;
constexpr size_t WT_IN = 0  , WT_GF = 8 * MiB, WT_GM = 10 * MiB, WT_UPF = 12 * MiB, WT_UPM = 13 * MiB, WT_MIX = 14 * MiB, WT_XQ = 16 * MiB, WT_XO = 18 * MiB,
                 WT_M1 = 20 * MiB, WT_M2 = 28 * MiB;
constexpr int NIN = 3072;
constexpr size_t WS_XK = 160 * MiB, XK_STRIDE = 8 * MiB + 2048;
constexpr size_t WS_XVT = 193 * MiB, XVT_STRIDE = 8 * MiB + 8192;
constexpr size_t WS_XN = 226 * MiB;
constexpr size_t WS_BIG = 354 * MiB, SLOT = 64 * MiB;
constexpr size_t WS_SSP = WS_BIG + 8 * SLOT;
constexpr size_t WS_CQK = WS_SSP + 4 * MiB;
constexpr size_t WS_END = WS_CQK + 128 * MiB;
constexpr int CW_TMO = 0, CW_CODE = 1, CW_BAR = 4096, CW_QUEUE = 8192;

constexpr int RING_OFF = 0, RING_BYTES = 131072;
constexpr int RSL_OFF = RING_BYTES, RSL_BYTES = 16384;
constexpr int RED_OFF = RSL_OFF + RSL_BYTES, RED_BYTES = 8192;
constexpr int LDS_BYTES = RED_OFF + RED_BYTES + 512;
constexpr int LDSCTL_OFF = LDS_BYTES - 512, MISC_OFF = LDSCTL_OFF + 320;
static_assert(WS_XK + 3 * XK_STRIDE + 8 * MiB <= WS_XVT && WS_XVT + 3 * XVT_STRIDE + 8 * MiB <= WS_XN && WS_XN + 128 * MiB <= WS_BIG && WS_MG + 64 * (5 * 4096 + 64) * 4 <= WS_W && WS_W + 4 * WL <= WS_XK && WS_END <= (size_t)1024 * MiB, "d_ws map");
struct Frame {
    LAS unsigned char* lds;
    volatile LAS unsigned* MISC;
    gu32* ctl;
    int tid, lane, wave;
    int vcu, G;
};
__device__ __forceinline__ float shx(float v, int o, int lane) { return __builtin_bit_cast(float, __builtin_amdgcn_ds_bpermute((lane ^ o) << 2, __builtin_bit_cast(int, v))); }
__device__ __forceinline__ float shup(float v, int o, int lane) { return __builtin_bit_cast(float, __builtin_amdgcn_ds_bpermute((lane - o) << 2, __builtin_bit_cast(int, v))); }
__device__ __forceinline__ float wave_sum(float v, int lane) {
#pragma unroll
    for (int o = 1; o < 64; o <<= 1) v += shx(v, o, lane);
    return v;
}
__device__ __forceinline__ float wave_max(float v, int lane) {
#pragma unroll
    for (int o = 1; o < 64; o <<= 1) v = fmaxf(v, shx(v, o, lane));
    return v;
}
__device__ __forceinline__ float bf2f(unsigned short b) { return __uint_as_float((unsigned)b << 16); }
__device__ __forceinline__ float logsigmoid(float x) { const float e = __builtin_amdgcn_exp2f(fabsf(x) * -1.4426950408889634f);
    return fminf(x, 0.f) - __builtin_amdgcn_logf(1.0f + e) * 0.6931471805599453f; }
__device__ __forceinline__ void unpack8(const v4u w, float* f) {
    f[0] = __uint_as_float(w.x << 16); f[1] = __uint_as_float(w.x & 0xffff0000u); f[2] = __uint_as_float(w.y << 16); f[3] = __uint_as_float(w.y & 0xffff0000u);
    f[4] = __uint_as_float(w.z << 16); f[5] = __uint_as_float(w.z & 0xffff0000u); f[6] = __uint_as_float(w.w << 16); f[7] = __uint_as_float(w.w & 0xffff0000u);
}

__device__ __forceinline__ void transpose_item(const float* W, int ld, int c0, int ncols, int K, bf16* WT, float scale, LAS float* scr, int item, int lane, const float* gain = nullptr) {
    const int nblk = ncols / 64, kb = item / nblk, nb = item % nblk, k0 = 64 * kb, n0 = 64 * nb;
    const int n4 = (lane & 15) * 4;
#pragma unroll 4
    for (int i = 0; i < 16; ++i) { const int kk = 4 * i + (lane >> 4); const float sc = gain ? scale * gain[k0 + kk] : scale;
        const f32x4 v = *(const GAS f32x4*)(W + (size_t)(k0 + kk) * ld + c0 + n0 + n4);
        LAS float* d = scr + kk * 65 + n4; d[0] = v.x * sc; d[1] = v.y * sc; d[2] = v.z * sc; d[3] = v.w * sc; }
    LDS_WAIT(); asm volatile("" ::: "memory");
    const int c = lane & 7;
#pragma unroll
    for (int j = 0; j < 8; ++j) { const int n = (lane >> 3) + 8 * j; const LAS float* s = scr + (8 * c) * 65 + n;
        v4u o; o.x = pk2(s[0 * 65], s[1 * 65]); o.y = pk2(s[2 * 65], s[3 * 65]); o.z = pk2(s[4 * 65], s[5 * 65]); o.w = pk2(s[6 * 65], s[7 * 65]);
        *(GAS v4u*)(WT + (size_t)(n0 + n) * K + k0 + 8 * c) = o; }
    LDS_WAIT(); asm volatile("" ::: "memory");
}
__device__ __forceinline__ unsigned pk4_f8(float a, float b, float c, float d) { int r = 0; r = __builtin_amdgcn_cvt_pk_fp8_f32(a, b, r, false); r = __builtin_amdgcn_cvt_pk_fp8_f32(c, d, r, true); return (unsigned)r; }
__device__ __forceinline__ void transpose_item_f8(const float* W, int ld, int c0, int ncols, int K, unsigned char* WT8, float scale, LAS float* scr, int item, int lane, const float* gain) {
    const int nblk = ncols / 64, kb = item / nblk, nb = item % nblk, k0 = 64 * kb, n0 = 64 * nb;
    const int n4 = (lane & 15) * 4;
#pragma unroll 4
    for (int i = 0; i < 16; ++i) { const int kk = 4 * i + (lane >> 4); const float sc = scale * gain[k0 + kk];
        const f32x4 v = *(const GAS f32x4*)(W + (size_t)(k0 + kk) * ld + c0 + n0 + n4);
        LAS float* d = scr + kk * 65 + n4; d[0] = v.x * sc; d[1] = v.y * sc; d[2] = v.z * sc; d[3] = v.w * sc; }
    LDS_WAIT(); asm volatile("" ::: "memory");
    const int c = lane & 3;
#pragma unroll
    for (int j = 0; j < 4; ++j) { const int n = (lane >> 2) + 16 * j; const LAS float* s = scr + (16 * c) * 65 + n;
        v4u o; o.x = pk4_f8(s[0 * 65], s[1 * 65], s[2 * 65], s[3 * 65]); o.y = pk4_f8(s[4 * 65], s[5 * 65], s[6 * 65], s[7 * 65]);
        o.z = pk4_f8(s[8 * 65], s[9 * 65], s[10 * 65], s[11 * 65]); o.w = pk4_f8(s[12 * 65], s[13 * 65], s[14 * 65], s[15 * 65]);
        *(GAS v4u*)(WT8 + (size_t)(n0 + n) * K + k0 + 16 * c) = o; }
    LDS_WAIT(); asm volatile("" ::: "memory");
}
__device__ __forceinline__ void copy_item(const float* W, bf16* Wc, float scale, int item, int lane, const float* gain) {
    const int kb = item >> 4, nb = item & 15, k0 = 64 * kb, n0 = 64 * nb, n4 = (lane & 15) * 4;
#pragma unroll 4
    for (int i = 0; i < 16; ++i) { const int kk = 4 * i + (lane >> 4); const float sc = scale * gain[k0 + kk];
        const f32x4 v = *(const GAS f32x4*)(W + (size_t)(k0 + kk) * DM + n0 + n4);
        *(GAS unsigned long long*)(Wc + (size_t)(k0 + kk) * DM + n0 + n4) = (unsigned long long)pk2(v.x * sc, v.y * sc) | ((unsigned long long)pk2(v.z * sc, v.w * sc) << 32); }
}
constexpr int ITEMS_PER_LAYER = 128 + 256 + 512 + 256 + 256 + 128 + 128 + 256 + 256 + 256 + 256 + 256 + 1024 + 1024;
#define KAS __attribute__((address_space(4)))
__device__ __forceinline__ void p0_prologue(Frame& F, const KAS char* ka, unsigned char* ws) {
#define PIN(k) (*(const float* const KAS*)(ka + 8 * (k)))
    LAS float* scr = (LAS float*)(F.lds + RING_OFF + F.wave * 16640);
    const int gw = F.vcu * NWAVES + F.wave, NGW = F.G * NWAVES;
    for (int it = gw; it < DEPTH * ITEMS_PER_LAYER; it += NGW) {
        const int l = it / ITEMS_PER_LAYER; int r = it % ITEMS_PER_LAYER;
        unsigned char* wl = ws + WS_W + (size_t)l * WL;
        const float* w_in = PIN(6) + (size_t)l * DM * INW;
        bf16* wtin = (bf16*)(wl + WT_IN);
        if (r < 128) { transpose_item(w_in, INW, 0, 512, DM, wtin, FOX_QS, scr, r, F.lane, PIN(2) + (size_t)l * DM); continue; } r -= 128;
        if (r < 256) { transpose_item(w_in, INW, 512, 1024, DM, wtin + (size_t)512 * DM, 1.f, scr, r, F.lane, PIN(2) + (size_t)l * DM); continue; } r -= 256;
        if (r < 384) { transpose_item(w_in, INW, 1544, 1536, DM, wtin + (size_t)1536 * DM, 1.f, scr, r, F.lane, PIN(2) + (size_t)l * DM); continue; } r -= 384;
        if (r < 128) { transpose_item_f8(w_in, INW, 1544 + 1536, 512, DM, wl + WT_IN + (size_t)3072 * DM * 2, GATE_WS, scr, r, F.lane, PIN(2) + (size_t)l * DM); continue; } r -= 128;
        if (r < 256) { transpose_item_f8(w_in, INW, 3600, 1024, DM, wl + WT_GF, GATE_WS, scr, r, F.lane, PIN(2) + (size_t)l * DM); continue; } r -= 256;
        if (r < 256) { transpose_item_f8(w_in, INW, 4624, 1024, DM, wl + WT_GF + (size_t)1024 * DM, GATE_WS, scr, r, F.lane, PIN(2) + (size_t)l * DM); continue; } r -= 256;
        if (r < 128) { transpose_item(PIN(14) + (size_t)l * 512 * DM, DM, 0, DM, 512, (bf16*)(wl + WT_UPF), 1.f, scr, r, F.lane); continue; } r -= 128;
        if (r < 128) { transpose_item(PIN(15) + (size_t)l * 512 * DM, DM, 0, DM, 512, (bf16*)(wl + WT_UPM), 1.f, scr, r, F.lane); continue; } r -= 128;
        if (r < 256) { transpose_item(PIN(16) + (size_t)l * DM * DM, DM, 0, DM, DM, (bf16*)(wl + WT_MIX), 1.f, scr, r, F.lane); continue; } r -= 256;
        if (r < 256) { copy_item(PIN(17) + (size_t)l * DM * DM, (bf16*)(wl + WT_XQ), X_QS, r, F.lane, PIN(3) + (size_t)l * DM); continue; } r -= 256;
        if (r < 256) { transpose_item(PIN(18) + (size_t)l * DM * 2 * DM, 2 * DM, 0, DM, DM, (bf16*)(ws + WS_BIG + (size_t)l * 2 * MiB), 1.f, scr, r, F.lane); continue; } r -= 256;
        if (r < 256) { transpose_item(PIN(18) + (size_t)l * DM * 2 * DM, 2 * DM, DM, DM, DM, (bf16*)(ws + WS_BIG + 8 * MiB + (size_t)l * 2 * MiB), 1.f, scr, r, F.lane); continue; } r -= 256;
        if (r < 256) { transpose_item(PIN(19) + (size_t)l * DM * DM, DM, 0, DM, DM, (bf16*)(wl + WT_XO), 1.f, scr, r, F.lane); continue; } r -= 256;
        if (r < 1024) { transpose_item(PIN(20) + (size_t)l * DM * DFF, DFF, 0, DFF, DM, (bf16*)(wl + WT_M1), 1.f, scr, r, F.lane, PIN(5) + (size_t)l * DM); continue; } r -= 1024;
        transpose_item(PIN(21) + (size_t)l * DFF * DM, DM, 0, DM, DFF, (bf16*)(wl + WT_M2), 1.f, scr, r, F.lane);
    }
    for (int idx = (F.vcu * NWAVES + F.wave) * 64 + F.lane; idx < DEPTH * 256 * DM; idx += F.G * NWAVES * 64) {
        const int l = idx >> 18, c = (idx >> 10) & 255, k = idx & 1023;
        float v = 0.f;
        if (c < 16) { const int col = c < 8 ? 1536 + c : (c < 12 ? 3592 + (c - 8) : 3596 + (c - 12)); v = PIN(6)[(size_t)l * DM * INW + (size_t)k * INW + col] * PIN(2)[(size_t)l * DM + k]; }
        ((bf16*)(ws + WS_W + (size_t)l * WL + WT_IN))[(size_t)(3584 + c) * DM + k] = (bf16)f2bf(v);
    }
    for (int m = gw; m < MROWS; m += NGW) {
        const GAS f32x4* xr = (const GAS f32x4*)(PIN(1) + (size_t)m * DM) + F.lane;
        f32x4 v[4]; float s2 = 0.f;
#pragma unroll
        for (int j = 0; j < 4; ++j) { v[j] = xr[64 * j]; s2 += (v[j].x * v[j].x + v[j].y * v[j].y) + (v[j].z * v[j].z + v[j].w * v[j].w); }
        const float r = 1.f / sqrtf(wave_sum(s2, F.lane) * (1.f / DM) + EPS);
#pragma unroll
        for (int l = 0; l < DEPTH; ++l) {
            GAS unsigned long long* o8 = (GAS unsigned long long*)(ws + WS_BIG + 16 * MiB + (size_t)l * 8 * MiB + (size_t)m * DM * 2) + F.lane;
#pragma unroll
            for (int j = 0; j < 4; ++j) { const f32x4 g = ((const GAS f32x4*)(PIN(4) + (size_t)l * DM))[F.lane + 64 * j];
                o8[64 * j] = (unsigned long long)pk2(v[j].x * r * g.x, v[j].y * r * g.y) | ((unsigned long long)pk2(v[j].z * r * g.z, v[j].w * r * g.w) << 32); }
        }
    }
}

__device__ __forceinline__ void x0_phase(Frame& F, const float* x, bf16* XN, float* SSP, unsigned char* XN8) {
    const int gw = F.vcu * NWAVES + F.wave, NGW = F.G * NWAVES;
    for (int m = gw; m < M; m += NGW) {
        const GAS f32x4* xr = (const GAS f32x4*)(x + (size_t)m * DM) + F.lane;
        f32x4 v[4]; float s2 = 0.f;
#pragma unroll
        for (int j = 0; j < 4; ++j) { v[j] = xr[64 * j]; s2 += (v[j].x * v[j].x + v[j].y * v[j].y) + (v[j].z * v[j].z + v[j].w * v[j].w); }
        s2 = wave_sum(s2, F.lane);
        GAS unsigned long long* o8 = (GAS unsigned long long*)(XN + (size_t)m * DM) + F.lane;
#pragma unroll
        for (int j = 0; j < 4; ++j) o8[64 * j] = (unsigned long long)pk2(v[j].x, v[j].y) | ((unsigned long long)pk2(v[j].z, v[j].w) << 32);
        { GAS unsigned* q8 = (GAS unsigned*)(XN8 + (size_t)m * DM) + F.lane;
#pragma unroll
          for (int j = 0; j < 4; ++j) q8[64 * j] = pk4_f8(v[j].x, v[j].y, v[j].z, v[j].w); }
        if (F.lane < 16) SSP[(size_t)m * 16 + F.lane] = (F.lane == 0) ? s2 : 0.f;
    }
}
__device__ __forceinline__ void gates_phase(Frame& F, const bf16* XN, const float* SSP, const bf16* WGB, const float* bff, const float* bmi, const float* bmf, float* FFL, float* IG, float* LF) {
    typedef short bf16x8_t __attribute__((ext_vector_type(8)));
    for (int i = F.tid; i < 16 * 128; i += NWAVES * 64) *(LAS v4u*)(F.lds + RING_OFF + (i >> 7) * 2064 + (i & 127) * 16) = *(const GAS v4u*)(WGB + (size_t)(i >> 7) * DM + (i & 127) * 8);
    __syncthreads();
    const int gw = F.vcu * NWAVES + F.wave, NGW = F.G * NWAVES, i16 = F.lane & 15, g = F.lane >> 4;
    const LAS unsigned char* bl = F.lds + RING_OFF + i16 * 2064 + g * 16;
    const float bias = i16 < 8 ? bff[i16] : (i16 < 12 ? bmi[i16 - 8] : bmf[i16 - 12]);
    for (int grp = gw; grp < M / 32; grp += NGW) {
        const size_t row0 = (size_t)grp * 32;
        f32x4 acc[2] = {{0.f, 0.f, 0.f, 0.f}, {0.f, 0.f, 0.f, 0.f}};
        const bf16* ap = XN + (row0 + i16) * DM + 8 * g;
#pragma unroll 8
        for (int ks = 0; ks < 32; ++ks) { const bf16x8_t b = *(const LAS bf16x8_t*)(bl + 64 * ks);
            acc[0] = __builtin_amdgcn_mfma_f32_16x16x32_bf16(*(const GAS bf16x8_t*)(ap + 32 * ks), b, acc[0], 0, 0, 0);
            acc[1] = __builtin_amdgcn_mfma_f32_16x16x32_bf16(*(const GAS bf16x8_t*)(ap + 16 * DM + 32 * ks), b, acc[1], 0, 0, 0); }
#pragma unroll
        for (int h = 0; h < 2; ++h)
#pragma unroll
            for (int r = 0; r < 4; ++r) { const size_t row = row0 + 16 * h + 4 * g + r;
                const f32x4 p0 = *(const GAS f32x4*)(SSP + row * 16), p1 = *(const GAS f32x4*)(SSP + row * 16 + 4), p2 = *(const GAS f32x4*)(SSP + row * 16 + 8), p3 = *(const GAS f32x4*)(SSP + row * 16 + 12);
                const float ss = (((p0[0] + p0[1]) + (p0[2] + p0[3])) + ((p1[0] + p1[1]) + (p1[2] + p1[3]))) + (((p2[0] + p2[1]) + (p2[2] + p2[3])) + ((p3[0] + p3[1]) + (p3[2] + p3[3])));
                const float v = acc[h][r] * (1.f / sqrtf(ss * (1.f / DM) + EPS)) + bias;
                if (i16 < 8) FFL[row * 8 + i16] = logsigmoid(v);
                else if (i16 < 12) IG[row * 4 + (i16 - 8)] = v;
                else LF[row * 4 + (i16 - 12)] = logsigmoid(v); }
    }
    __syncthreads();
}

__device__ __forceinline__ void fox_scan(Frame& F, const float* FFL, float* CN2) {
    LAS float* wt = (LAS float*)(F.lds + RING_OFF);
    for (int seq = blockIdx.x; seq < NB * 8; seq += gridDim.x) {
        const int b = seq >> 3, hh = seq & 7;
        const float* src = FFL + (size_t)b * SEQ * 8 + hh;
        float x[8]; float run = 0.f;
#pragma unroll
        for (int k = 0; k < 8; ++k) { run += src[(size_t)(F.tid * 8 + k) * 8]; x[k] = run; }
        float incl = run;
#pragma unroll
        for (int o = 1; o < 64; o <<= 1) { const float t = shup(incl, o, F.lane); if (F.lane >= o) incl += t; }
        if (F.lane == 63) wt[F.wave] = incl;
        __syncthreads();
        float off = 0.f;
#pragma unroll
        for (int w = 0; w < NWAVES; ++w) if (w < F.wave) off += wt[w];
        const float excl = off + incl - run;
#pragma unroll
        for (int k = 0; k < 8; ++k) CN2[(size_t)seq * SEQ + F.tid * 8 + k] = -LOG2E * (excl + x[k]);
        __syncthreads();
    }
}

__device__ __forceinline__ void conv_phase(Frame& F, const bf16* MQK, bf16* CQK, const float* conv_w, const float* conv_b) {
    const int gw = F.vcu * NWAVES + F.wave, NGW = F.G * NWAVES;
    for (int task = gw; task < (M / 64) * 2; task += NGW) {
        const int tb = task >> 1, half = task & 1, gc = half * 512 + F.lane * 8;
        float cw[4][8], cb[8];
#pragma unroll
        for (int j = 0; j < 4; ++j) { const f32x4 a = *(const GAS f32x4*)(conv_w + j * 1024 + gc), bq = *(const GAS f32x4*)(conv_w + j * 1024 + gc + 4);
            cw[j][0] = a[0]; cw[j][1] = a[1]; cw[j][2] = a[2]; cw[j][3] = a[3]; cw[j][4] = bq[0]; cw[j][5] = bq[1]; cw[j][6] = bq[2]; cw[j][7] = bq[3]; }
        { const f32x4 a = *(const GAS f32x4*)(conv_b + gc), bq = *(const GAS f32x4*)(conv_b + gc + 4); cb[0] = a[0]; cb[1] = a[1]; cb[2] = a[2]; cb[3] = a[3]; cb[4] = bq[0]; cb[5] = bq[1]; cb[6] = bq[2]; cb[7] = bq[3]; }
        const float osc = half ? ML_KS : 1.f;
        const size_t row0 = (size_t)tb * 64; const bool first = (tb & 63) == 0;
        float x0[8], x1[8], x2[8];
        { v4u w0 = {0u, 0u, 0u, 0u}, w1 = w0, w2 = w0;
          if (!first) { w0 = *(const GAS v4u*)(MQK + (row0 - 3) * 1024 + gc); w1 = *(const GAS v4u*)(MQK + (row0 - 2) * 1024 + gc); w2 = *(const GAS v4u*)(MQK + (row0 - 1) * 1024 + gc); }
          unpack8(w0, x0); unpack8(w1, x1); unpack8(w2, x2); }
#pragma unroll 4
        for (int t = 0; t < 64; ++t) { float x3[8]; unpack8(*(const GAS v4u*)(MQK + (row0 + t) * 1024 + gc), x3); float y[8];
#pragma unroll
            for (int ch = 0; ch < 8; ++ch) { const float v = cb[ch] + cw[0][ch] * x0[ch] + cw[1][ch] * x1[ch] + cw[2][ch] * x2[ch] + cw[3][ch] * x3[ch];
                y[ch] = osc * v * __builtin_amdgcn_rcpf(1.f + __expf(-v)); x0[ch] = x1[ch]; x1[ch] = x2[ch]; x2[ch] = x3[ch]; }
            v4u o; o.x = pk2(y[0], y[1]); o.y = pk2(y[2], y[3]); o.z = pk2(y[4], y[5]); o.w = pk2(y[6], y[7]);
            *(GAS v4u*)(CQK + (row0 + t) * 1024 + gc) = o; }
    }
}

__device__ __forceinline__ void final_norm(Frame& F, const bf16* H, float* out, const float* gain) {
    const int gw = F.vcu * NWAVES + F.wave, NGW = F.G * NWAVES;
    f32x4 g4[4];
#pragma unroll
    for (int j = 0; j < 4; ++j) g4[j] = ((const GAS f32x4*)gain)[F.lane + 64 * j];
    for (int m = gw; m < M; m += NGW) {
        const GAS unsigned long long* hr = (const GAS unsigned long long*)(H + (size_t)m * DM) + F.lane;
        GAS f32x4* xr = (GAS f32x4*)(out + (size_t)m * DM) + F.lane;
        f32x4 v[4]; float s2 = 0.f;
#pragma unroll
        for (int j = 0; j < 4; ++j) { const unsigned long long w = hr[64 * j];
            v[j] = (f32x4){__uint_as_float((unsigned)w << 16), __uint_as_float((unsigned)w & 0xffff0000u), __uint_as_float((unsigned)(w >> 32) << 16), __uint_as_float((unsigned)(w >> 32) & 0xffff0000u)};
            s2 += (v[j].x * v[j].x + v[j].y * v[j].y) + (v[j].z * v[j].z + v[j].w * v[j].w); }
        const float r = 1.f / sqrtf(wave_sum(s2, F.lane) * (1.f / DM) + EPS);
#pragma unroll
        for (int j = 0; j < 4; ++j) xr[64 * j] = v[j] * r * g4[j];
    }
}
namespace ml {
typedef short bf16x8 __attribute__((ext_vector_type(8)));
typedef short s16x4 __attribute__((ext_vector_type(4)));
typedef float f32x4 __attribute__((ext_vector_type(4)));
typedef unsigned u32x4 __attribute__((ext_vector_type(4)));
typedef unsigned u32x2 __attribute__((ext_vector_type(2)));
constexpr int IMG = 64 * 272, QI = 0, KI = IMG, VI = 2 * IMG, VWI = 3 * IMG, PI = 4 * IMG, RSP = PI + 64 * 144, QNP = RSP + 1024, NRM = QNP + 2048, NV = NRM + 2048, NVP = NV + 512  , GSC = NVP + 2048  , BC = GSC + 1536, PM = BC + 16384, BLA = PM + 16384, MLA = BLA + 256, MPA = MLA + 256, MNA = MPA + 256, LDS_END = MNA + 256;
static_assert(LDS_END <= 131072, "mLSTM LDS map");
constexpr int MG_STRIDE = 5 * 4096 + 64;
__device__ __forceinline__ unsigned off_b(unsigned row, unsigned ch) { return 272u * row + 16u * ch; }
__device__ __forceinline__ unsigned cvtpk(float lo, float hi) { typedef float f2 __attribute__((ext_vector_type(2))); typedef __bf16 b2 __attribute__((ext_vector_type(2))); f2 v = {lo, hi}; b2 b = __builtin_convertvector(v, b2); return __builtin_bit_cast(unsigned, b); }
__device__ __forceinline__ float blo(unsigned w) { return __uint_as_float(w << 16); }
__device__ __forceinline__ float bhi(unsigned w) { return __uint_as_float(w & 0xffff0000u); }
#define ML_LDS(T, off) ((__attribute__((address_space(3))) T*)(lds + (off)))
__device__ __forceinline__ bf16x8 rd128(LAS unsigned char* lds, unsigned off) { return *(const __attribute__((address_space(3))) bf16x8*)(lds + off); }
__device__ __forceinline__ s16x4 rdtr(LAS unsigned char* lds, unsigned off) { typedef short v4i16_t __attribute__((ext_vector_type(4))); return __builtin_bit_cast(s16x4, __builtin_amdgcn_ds_read_tr16_b64_v4i16((__attribute__((address_space(3))) v4i16_t*)(lds + off))); }
__device__ __forceinline__ s16x4 rd64(LAS unsigned char* lds, unsigned off) { return *(const __attribute__((address_space(3))) s16x4*)(lds + off); }
__device__ __forceinline__ bf16x8 cat(s16x4 a, s16x4 b) { return (bf16x8){a[0], a[1], a[2], a[3], b[0], b[1], b[2], b[3]}; }
#define ML_MFMA(a, b, c) __builtin_amdgcn_mfma_f32_16x16x32_bf16(a, b, c, 0, 0, 0)
#define ML_BAR() do { asm volatile("s_waitcnt lgkmcnt(0)" ::: "memory"); __builtin_amdgcn_s_barrier(); asm volatile("" ::: "memory"); } while (0)

__device__ __forceinline__ void mlstm_unit(LAS unsigned char* lds, int tid_in, int b, int hh, const bf16* CQK, const bf16* MV, bf16* MO, const float* IG, const float* LF, const float* mnorm, float* MG) {
    const size_t tokb = (size_t)b * SEQ;
    int tid0 = tid_in; asm volatile("" : "+v"(tid0));
#define ML_IDX(T) const int tid = (T), lane = tid & 63, w = __builtin_amdgcn_readfirstlane(tid >> 6), i16 = lane & 15, g = lane >> 4; (void)i16; (void)g; (void)w; (void)lane
    float* U2 = MG; float* W2 = MG + 4096; float* IWA = MG + 8192; float* EMT = MG + 12288; float* WKA = MG + 16384; float* SOLD = MG + 20480;
    {   ML_IDX(tid0);
        for (int c = w; c < 64; c += 8) {
            const float ig = IG[(tokb + c * 64 + lane) * 4 + hh], lf = LF[(tokb + c * 64 + lane) * 4 + hh];
            float bc = lf;
#pragma unroll
            for (int o = 1; o < 64; o <<= 1) { const float t = shup(bc, o, lane); if (lane >= o) bc += t; }
            const float bL = __builtin_bit_cast(float, __builtin_amdgcn_readlane(__builtin_bit_cast(int, bc), 63));
            const float a = bL - bc + ig, mloc = wave_max(a, lane);
            float pm = ig - bc;
#pragma unroll
            for (int o = 1; o < 64; o <<= 1) { const float t = shup(pm, o, lane); if (lane >= o) pm = fmaxf(pm, t); }
            ML_LDS(float, BC)[c * 64 + lane] = bc; ML_LDS(float, PM)[c * 64 + lane] = pm;
            if (lane == 0) { ML_LDS(float, BLA)[c] = bL; ML_LDS(float, MLA)[c] = mloc; }
        }
        __syncthreads();
        if (tid == 0) { float m = 0.f;
            for (int c = 0; c < 64; ++c) { const float bL = ML_LDS(float, BLA)[c], mn = fmaxf(bL + m, ML_LDS(float, MLA)[c]);
                ML_LDS(float, MPA)[c] = m; ML_LDS(float, MNA)[c] = mn; SOLD[c] = expf(bL + m - mn); m = mn; } }
        __syncthreads();
#pragma unroll 1
        for (int k = 0; k < 8; ++k) { const int t = tid + 512 * k, c = t >> 6;
            const float ig = IG[(tokb + t) * 4 + hh], bc = ML_LDS(float, BC)[t], pm = ML_LDS(float, PM)[t], bL = ML_LDS(float, BLA)[c], mp = ML_LDS(float, MPA)[c], mn = ML_LDS(float, MNA)[c];
            const float il = bc + mp, mt = fmaxf(il, bc + pm);
            U2[t] = (bc - mt) * LOG2E; W2[t] = (ig - bc) * LOG2E; IWA[t] = expf(il - mt); EMT[t] = expf(-mt); WKA[t] = expf(bL - bc + ig - mn); }
        if (tid < 128) ML_LDS(float, NV)[tid] = 0.f;
        asm volatile("s_waitcnt vmcnt(0)" ::: "memory");
        __syncthreads();
    }
    float mng0, mng1, mng2, mng3;
    {   int tid1 = tid_in; asm volatile("" : "+v"(tid1)); ML_IDX(tid1);
        mng0 = mnorm[hh * 128 + 16 * w + 4 * g]; mng1 = mnorm[hh * 128 + 16 * w + 4 * g + 1]; mng2 = mnorm[hh * 128 + 16 * w + 4 * g + 2]; mng3 = mnorm[hh * 128 + 16 * w + 4 * g + 3];
    }
    f32x4 Ct[8];
#pragma unroll
    for (int t = 0; t < 8; ++t) Ct[t] = (f32x4){0.f, 0.f, 0.f, 0.f};
    float nreg = 0.f;
    u32x4 raw[4], vpre[2]; float wkpre[2]; float gpre[5]; float sopre;
#define ML_PREFETCH(cc) do { \
        _Pragma("unroll") for (int k_ = 0; k_ < 4; ++k_) raw[k_] = *(const GAS u32x4*)(CQK + (tokb + (cc) * 64 + 4 * tg + k_) * 1024 + gc); \
        _Pragma("unroll") for (int k_ = 0; k_ < 2; ++k_) { vpre[k_] = *(const GAS u32x4*)(MV + (tokb + (cc) * 64 + vrow0 + 32 * k_) * 512 + hh * 128 + vch * 8); wkpre[k_] = WKA[(cc) * 64 + vrow0 + 32 * k_]; } \
        if (tid < 64) { _Pragma("unroll") for (int a_ = 0; a_ < 5; ++a_) gpre[a_] = MG[a_ * 4096 + (cc) * 64 + tid]; sopre = SOLD[(cc)]; } } while (0)
#define ML_JOB const int kind = tid >> 8, ch8 = (tid >> 4) & 15, tg = tid & 15, gc = kind * 512 + hh * 128 + ch8 * 8, vrow0 = tid >> 4, vch = tid & 15, st = w >> 1, lt0 = 2 * (w & 1); (void)kind; (void)ch8; (void)st; (void)lt0
    { int tid2 = tid_in; asm volatile("" : "+v"(tid2)); ML_IDX(tid2); ML_JOB; ML_PREFETCH(0); }
#pragma unroll 1
    for (int c = 0; c < 64; ++c) {
        int tid_c = tid_in; asm volatile("" : "+v"(tid_c)); ML_IDX(tid_c); ML_JOB;
        const size_t tok0 = tokb + c * 64;
        u32x2 moc[4];
#pragma unroll
        for (int lt = 0; lt < 4; ++lt) moc[lt] = *(const GAS u32x2*)(MO + (tok0 + 16 * lt + i16) * 512 + hh * 128 + 16 * w + 4 * g);
        {
#pragma unroll
            for (int i = 0; i < 4; ++i) *ML_LDS(u32x4, (kind ? KI : QI) + off_b(4 * tg + i, ch8)) = raw[i];
#pragma unroll
            for (int k = 0; k < 2; ++k) { const int row = vrow0 + 32 * k; const u32x4 v = vpre[k]; const float s = wkpre[k];
                *ML_LDS(u32x4, VI + off_b(row, vch)) = v;
                const u32x4 o = {cvtpk(blo(v.x) * s, bhi(v.x) * s), cvtpk(blo(v.y) * s, bhi(v.y) * s), cvtpk(blo(v.z) * s, bhi(v.z) * s), cvtpk(blo(v.w) * s, bhi(v.w) * s)};
                *ML_LDS(u32x4, VWI + off_b(row, vch)) = o; }
        }
        if (tid < 64) {
#pragma unroll
            for (int a = 0; a < 5; ++a) ML_LDS(float, GSC)[a * 64 + tid] = gpre[a];
            if (tid == 0) ML_LDS(float, GSC)[320] = sopre; }
        if (c + 1 < 64) ML_PREFETCH(c + 1);
        ML_BAR();
        const float u2a = ML_LDS(float, GSC)[16 * lt0 + i16], u2b = ML_LDS(float, GSC)[16 * (lt0 + 1) + i16];
        const f32x4 w2v = *ML_LDS(f32x4, GSC + (64 + 16 * st + 4 * g) * 4);
        float iwv[4], emv[4];
#pragma unroll
        for (int lt = 0; lt < 4; ++lt) { iwv[lt] = ML_LDS(float, GSC)[128 + 16 * lt + i16]; emv[lt] = ML_LDS(float, GSC)[192 + 16 * lt + i16]; }
        const float s_old = ML_LDS(float, GSC)[320];
        {
            f32x4 s0 = {0.f, 0.f, 0.f, 0.f}, s1 = {0.f, 0.f, 0.f, 0.f};
#pragma unroll
            for (int ks = 0; ks < 4; ++ks) { const bf16x8 ka = rd128(lds, KI + off_b(i16 + 16 * st, 4 * ks + g));
                s0 = ML_MFMA(ka, rd128(lds, QI + off_b(i16 + 16 * lt0, 4 * ks + g)), s0); s1 = ML_MFMA(ka, rd128(lds, QI + off_b(i16 + 16 * (lt0 + 1), 4 * ks + g)), s1); }
#pragma unroll
            for (int q = 0; q < 2; ++q) { const int lt = lt0 + q; const f32x4 sv = q ? s1 : s0; const float u2 = q ? u2b : u2a; const int l = 16 * lt + i16; float p[4]; float ps = 0.f;
#pragma unroll
                for (int r = 0; r < 4; ++r) { const int s = 16 * st + 4 * g + r; const float v = sv[r] * __builtin_amdgcn_exp2f(u2 + w2v[r]); p[r] = (s <= l) ? v : 0.f; ps += p[r]; }
                ps = pg8::fq_sum(ps);
                if (g == 0) ML_LDS(float, RSP)[st * 64 + l] = ps;
                const u32x2 o = {cvtpk(p[0], p[1]), cvtpk(p[2], p[3])};
                *ML_LDS(u32x2, PI + 144 * l + 32 * st + 8 * g) = o; }
            { const int l = tid & 63, dp = tid >> 6; float acc = 0.f;
#pragma unroll
              for (int h2 = 0; h2 < 2; ++h2) { const u32x4 qv = *ML_LDS(u32x4, QI + off_b(l, 2 * dp + h2)); const f32x4 n0 = *ML_LDS(f32x4, NV + (16 * dp + 8 * h2) * 4), n1 = *ML_LDS(f32x4, NV + (16 * dp + 8 * h2 + 4) * 4);
                  acc += (blo(qv.x) * n0[0] + bhi(qv.x) * n0[1]) + (blo(qv.y) * n0[2] + bhi(qv.y) * n0[3]) + (blo(qv.z) * n1[0] + bhi(qv.z) * n1[1]) + (blo(qv.w) * n1[2] + bhi(qv.w) * n1[3]); }
              ML_LDS(float, QNP)[dp * 64 + l] = acc; }
        }
        ML_BAR();
        f32x4 H[4];
        {
            float inv[4];
#pragma unroll
            for (int lt = 0; lt < 4; ++lt) { const int l = 16 * lt + i16; float rs = 0.f, qn = 0.f;
#pragma unroll
                for (int k = 0; k < 4; ++k) rs += ML_LDS(float, RSP)[k * 64 + l];
#pragma unroll
                for (int k = 0; k < 8; ++k) qn += ML_LDS(float, QNP)[k * 64 + l];
                const float den = iwv[lt] * qn + rs; inv[lt] = __builtin_amdgcn_rcpf(fmaxf(fabsf(den), emv[lt])); }
            f32x4 hi_[4], hx_[4];
#pragma unroll
            for (int lt = 0; lt < 4; ++lt) { hi_[lt] = (f32x4){0.f, 0.f, 0.f, 0.f}; hx_[lt] = (f32x4){0.f, 0.f, 0.f, 0.f}; }
#define ML_SB() __builtin_amdgcn_sched_barrier(0)
#define ML_QB(kk_, lt_) cat(rd64(lds, QI + off_b(i16 + 16 * (lt_), 4 * (kk_) + (g >> 1)) + 8 * (g & 1)), rd64(lds, QI + off_b(i16 + 16 * (lt_), 4 * (kk_) + 2 + (g >> 1)) + 8 * (g & 1)))
            { bf16x8 qa[4][4];
#pragma unroll
              for (int kk = 0; kk < 4; ++kk)
#pragma unroll
                  for (int lt = 0; lt < 4; ++lt) qa[kk][lt] = ML_QB(kk, lt);
              ML_SB();
#pragma unroll
              for (int kk = 0; kk < 4; ++kk) { const u32x4 ca = {cvtpk(Ct[2 * kk][0], Ct[2 * kk][1]), cvtpk(Ct[2 * kk][2], Ct[2 * kk][3]), cvtpk(Ct[2 * kk + 1][0], Ct[2 * kk + 1][1]), cvtpk(Ct[2 * kk + 1][2], Ct[2 * kk + 1][3])};
#pragma unroll
                  for (int lt = 0; lt < 4; ++lt) hi_[lt] = ML_MFMA(__builtin_bit_cast(bf16x8, ca), qa[kk][lt], hi_[lt]); } }
            const unsigned trq = (lane & 15) >> 2, trp = lane & 3;
#pragma unroll
            for (int ks = 0; ks < 2; ++ks) { const bf16x8 va = cat(rdtr(lds, VI + off_b(32 * ks + 8 * g + trq, 2 * w + (trp >> 1)) + 8 * (trp & 1)), rdtr(lds, VI + off_b(32 * ks + 8 * g + 4 + trq, 2 * w + (trp >> 1)) + 8 * (trp & 1)));
#pragma unroll
                for (int lt = 0; lt < 4; ++lt) { const unsigned l = i16 + 16 * lt; hx_[lt] = ML_MFMA(va, rd128(lds, PI + 144 * l + 64 * ks + 16 * g), hx_[lt]); } }
#pragma unroll
            for (int lt = 0; lt < 4; ++lt) { H[lt] = (hi_[lt] * iwv[lt] + hx_[lt]) * inv[lt];
                float ss = (H[lt][0] * H[lt][0] + H[lt][1] * H[lt][1]) + (H[lt][2] * H[lt][2] + H[lt][3] * H[lt][3]);
                ss = pg8::fq_sum(ss);
                if (g == 0) ML_LDS(float, NRM)[w * 64 + 16 * lt + i16] = ss; }
#pragma unroll
            for (int t = 0; t < 8; ++t) Ct[t] = Ct[t] * s_old;
#define ML_KA(ks_, t_) cat(rdtr(lds, KI + off_b(32 * (ks_) + 8 * g + trq, 2 * (t_) + (trp >> 1)) + 8 * (trp & 1)), rdtr(lds, KI + off_b(32 * (ks_) + 8 * g + 4 + trq, 2 * (t_) + (trp >> 1)) + 8 * (trp & 1)))
#define ML_VB(ks_) cat(rdtr(lds, VWI + off_b(32 * (ks_) + 8 * g + trq, 2 * w + (trp >> 1)) + 8 * (trp & 1)), rdtr(lds, VWI + off_b(32 * (ks_) + 8 * g + 4 + trq, 2 * w + (trp >> 1)) + 8 * (trp & 1)))
            { bf16x8 ka[4], kn[4]; const bf16x8 vb0 = ML_VB(0), vb1 = ML_VB(1);
#pragma unroll
              for (int t = 0; t < 4; ++t) ka[t] = ML_KA(0, t);
              ML_SB();
#pragma unroll
              for (int grp = 0; grp < 4; ++grp) { const int ks = grp >> 1, tb = 4 * (grp & 1);
                  if (grp < 3) { const int ks2 = (grp + 1) >> 1, tb2 = 4 * ((grp + 1) & 1);
#pragma unroll
                      for (int t = 0; t < 4; ++t) kn[t] = ML_KA(ks2, tb2 + t); }
                  ML_SB();
#pragma unroll
                  for (int t = 0; t < 4; ++t) Ct[tb + t] = ML_MFMA(ka[t], ks ? vb1 : vb0, Ct[tb + t]);
                  ML_SB();
#pragma unroll
                  for (int t = 0; t < 4; ++t) ka[t] = kn[t]; } }
            { const int d = tid & 127, sq = tid >> 7; float acc = 0.f;
#pragma unroll
                for (int s = 0; s < 16; ++s) acc += ML_LDS(float, GSC)[256 + 16 * sq + s] * bf2f(*ML_LDS(unsigned short, KI + off_b(16 * sq + s, d >> 3) + 2 * (d & 7)));
                ML_LDS(float, NVP)[sq * 128 + d] = acc; }
        }
        ML_BAR();
        if (tid < 128) { nreg = s_old * nreg + ((ML_LDS(float, NVP)[tid] + ML_LDS(float, NVP)[128 + tid]) + (ML_LDS(float, NVP)[256 + tid] + ML_LDS(float, NVP)[384 + tid])); ML_LDS(float, NV)[tid] = nreg; }
#pragma unroll
        for (int lt = 0; lt < 4; ++lt) { const int l = 16 * lt + i16; float ss = 0.f;
#pragma unroll
            for (int k = 0; k < 8; ++k) ss += ML_LDS(float, NRM)[k * 64 + l];
            const float rs = __builtin_amdgcn_rsqf(ss * (1.f / 128.f) + EPS);
            const float m0 = blo(moc[lt].x), m1 = bhi(moc[lt].x), m2 = blo(moc[lt].y), m3 = bhi(moc[lt].y);
            const float y0 = H[lt][0] * rs * mng0 * m0, y1 = H[lt][1] * rs * mng1 * m1, y2 = H[lt][2] * rs * mng2 * m2, y3 = H[lt][3] * rs * mng3 * m3;
            *(GAS u32x2*)(MO + (tok0 + l) * 512 + hh * 128 + 16 * w + 4 * g) = (u32x2){cvtpk(y0, y1), cvtpk(y2, y3)}; }
    }
#undef ML_PREFETCH
#undef ML_SB
#undef ML_QB
#undef ML_KA
#undef ML_VB
#undef ML_IDX
#undef ML_JOB
}
#undef ML_LDS
#undef ML_MFMA
#undef ML_BAR
}
#ifndef MK_PER_PHASE
#define MK_PER_PHASE 0
#endif
#ifndef LAYERS_TEST
#define LAYERS_TEST DEPTH
#endif
#ifndef SITE_MASK
#define SITE_MASK 0xffffffffu
#endif
#define SITE_ON(k) ((SITE_MASK >> (k)) & 1u)
constexpr int PH_PER_LAYER = 16, NPH = 2 + DEPTH * PH_PER_LAYER + 1;
struct Args { const float* in[23]; float* out; unsigned char* ws; int ph_lo, ph_hi; };
__global__ void __launch_bounds__(NWAVES * 64, 2) trunk_fwd(Args args) {
    extern __shared__ __attribute__((aligned(16))) unsigned char lds[];
#if defined(PROBE_MASK)
    const unsigned long long pk0_ = __builtin_amdgcn_s_memrealtime();
#endif
    Frame F;
    F.lds = (LAS unsigned char*)lds;
    F.MISC = (volatile LAS unsigned*)(F.lds + MISC_OFF);
    F.tid = threadIdx.x; F.lane = F.tid & 63; F.wave = __builtin_amdgcn_readfirstlane(F.tid >> 6);
    F.G = gridDim.x; { const int bx = blockIdx.x; F.vcu = (F.G % 8 == 0) ? (bx % 8) * (F.G / 8) + bx / 8 : bx; }
    F.ctl = (gu32*)(args.ws + WS_CTL);
    for (int u = F.tid; u < (LDS_BYTES - LDSCTL_OFF) / 4; u += NWAVES * 64) ((LAS unsigned*)(F.lds + LDSCTL_OFF))[u] = 0u;
    __syncthreads();
    XcdBarrier bar; bar.bar = (unsigned*)(F.ctl + CW_BAR); bar.x = 0; bar.st = nullptr;
    if (!MK_PER_PHASE) bar = xcd_barrier_post((unsigned*)(F.ctl + CW_BAR), F.MISC + 8);
    const int lo = args.ph_lo, hi = args.ph_hi;
#define IN(k) (lo <= (k) && (k) < hi)
#if defined(PROBE_MASK)
#ifndef PROBE_LAYER
#define PROBE_LAYER -1
#endif
#ifndef PROBE_OFS
#define PROBE_OFS 0
#endif
#define PROBE_SEL(k) (((((k) < 2) ? (PROBE_MASK >> 16) : ((k) == NPH - 1) ? (PROBE_MASK >> 17) : (PROBE_MASK >> (((k) - 2) % PH_PER_LAYER))) & 1u) && (PROBE_LAYER < 0 || ((k) - 2) / PH_PER_LAYER == PROBE_LAYER))
#define PROBE_T0() do { if (blockIdx.x == 0 && threadIdx.x == 0) { const unsigned long long t_ = __builtin_amdgcn_s_memrealtime(); F.MISC[18] = (unsigned)t_; F.MISC[19] = (unsigned)(t_ >> 32); } } while (0)
#define PROBE_ACC(k) do { if (PROBE_SEL(k) && blockIdx.x == 0 && threadIdx.x == 0) { const unsigned long long d_ = __builtin_amdgcn_s_memrealtime() - ((unsigned long long)F.MISC[18] | ((unsigned long long)F.MISC[19] << 32)); F.MISC[16] = F.MISC[16] + (unsigned)d_; } } while (0)
#else
#define PROBE_T0() do {} while (0)
#define PROBE_ACC(k) do {} while (0)
#endif
#define SEAM(k) do { if (!MK_PER_PHASE && IN((k) + 1)) xcd_barrier(bar); PROBE_ACC(k); } while (0)
#define SEAM_L(k) do { if (!MK_PER_PHASE && IN((k) + 1)) { if (LOCAL_SEAMS && F.MISC[10]) xcd_barrier_local(bar); else xcd_barrier(bar); } PROBE_ACC(k); } while (0)
#ifndef LOCAL_SEAMS
#define LOCAL_SEAMS 1
#endif
#ifndef XPRE_GRP
#define XPRE_GRP 1
#endif
#ifndef STAG2_ON
#define STAG2_ON 0
#endif
#ifndef STAG_ON
#define STAG_ON 0
#endif
#define STAGGER_N(ngrp, us) do { if (STAG2_ON) { const unsigned long long t0_ = __builtin_amdgcn_s_memrealtime(); const unsigned long long d_ = (unsigned long long)((gB >> 3) & ((ngrp) - 1)) * (unsigned long long)(us) * 100ull; while (__builtin_amdgcn_s_memrealtime() - t0_ < d_) __builtin_amdgcn_s_sleep(8); } } while (0)
#define STAGGER(us) do { if (STAG_ON && (gB & 1)) { const unsigned long long t0_ = __builtin_amdgcn_s_memrealtime(); while (__builtin_amdgcn_s_memrealtime() - t0_ < (unsigned long long)(us) * 100ull) __builtin_amdgcn_s_sleep(8); } } while (0)
#define SEAM0(k, cond) do { if (!MK_PER_PHASE && IN((k) + 1) && (cond)) xcd_barrier(bar); PROBE_ACC(k); } while (0)
    constexpr size_t SL = SLOT / 2;

#define SITE_CTX(lay) const KAS char* ka = (const KAS char*)__builtin_amdgcn_kernarg_segment_ptr(); asm volatile("" : "+s"(ka)); \
    int ll = (lay); asm volatile("" : "+s"(ll)); int gG = F.G, gB = (int)blockIdx.x; asm volatile("" : "+s"(gG), "+s"(gB)); int gC = (LOCAL_SEAMS && F.MISC[10]) ? (int)(F.MISC[11] * 8u + bar.x) : gB; gC = __builtin_amdgcn_readfirstlane(gC); (void)gC;       Frame Fl = F; { int t_ = threadIdx.x; asm volatile("" : "+v"(t_)); Fl.tid = t_; Fl.lane = t_ & 63; int w_ = __builtin_amdgcn_readfirstlane(t_ >> 6), v_ = F.vcu; asm volatile("" : "+s"(w_), "+s"(v_)); Fl.wave = w_; Fl.vcu = v_; Fl.G = gG; } \
    unsigned char* ws = *(unsigned char* const KAS*)(ka + 192); float* out = *(float* const KAS*)(ka + 184); const float* x = INP(0); \
    unsigned char* wl = ws + WS_W + (size_t)ll * WL; const float* hin0 = (ll == 0) ? x : out; bf16* XN = (bf16*)(ws + WS_XN); bf16* BIG = (bf16*)(ws + WS_BIG); \
    float* FFL = (float*)(ws + WS_FFL); float* IG = (float*)(ws + WS_IG); float* LF = (float*)(ws + WS_LF); float* CN2 = (float*)(ws + WS_CN2); \
    (void)wl; (void)hin0; (void)gG; (void)gB; (void)XN; (void)BIG; (void)FFL; (void)IG; (void)LF; (void)CN2; (void)x; (void)out
#define INP(k) (*(const float* const KAS*)(ka + 8 * (k)))
    static_assert(sizeof(Args) == 208, "kernarg layout: in[23] at 0, out at 184, ws at 192, ph_lo at 200, ph_hi at 204");

    if (IN(0)) { SITE_CTX(0); PROBE_T0(); p0_prologue(Fl, ka, ws); x0_phase(Fl, x, XN, (float*)(ws + WS_SSP), (unsigned char*)out); SEAM(0); }
    if (IN(1)) { SITE_CTX(0); PROBE_T0();
        const bf16* memn = (const bf16*)(ws + WS_BIG + 16 * MiB);
        const bf16* wxk = (const bf16*)(ws + WS_BIG); const bf16* wxv = (const bf16*)(ws + WS_BIG + 8 * MiB);
        { pg8::Gemm g{memn, wxk, DEPTH * MROWS, DEPTH * DM, DM}; pg8::DiagOrder S{gG, gB, true};
          pg8::EpiB<0> E{(bf16*)(ws + WS_XK), DM, nullptr, nullptr, nullptr, nullptr, nullptr};
#if SITE_ON(0)
          pg8::gemm_phase<pg8::EpiB<0>, pg8::DiagOrder, true, true>(F.lds + RING_OFF, g, S, E);
#endif
        }
        { pg8::Gemm g{memn, wxv, DEPTH * MROWS, DEPTH * DM, DM}; pg8::DiagOrder S{gG, gB, true};
          pg8::EpiB<0> E{(bf16*)(ws + WS_XVT), DM, nullptr, nullptr, nullptr, nullptr, nullptr};
#if SITE_ON(1)
          pg8::gemm_phase<pg8::EpiB<0>, pg8::DiagOrder, true, true>(F.lds + RING_OFF, g, S, E);
#endif
        }
        SEAM(1);
    }
    for (int l = 0; l < LAYERS_TEST; ++l) {
        const int pb = 2 + PH_PER_LAYER * l;
        if (IN(pb + 1)) { SITE_CTX(l); PROBE_T0();
            gates_phase(Fl, XN, (const float*)(ws + WS_SSP), (const bf16*)(wl + WT_IN) + (size_t)3584 * DM, INP(7) + ll * 8, INP(8) + ll * 4, INP(9) + ll * 4, FFL, IG, LF);
            pg8::Gemm g{XN, (const bf16*)(wl + WT_IN), M, NIN, DM}; pg8::StaticOrder S; S.init(M, NIN, gG, gB);
            pg8::EpiIn E{(LAS float*)(F.lds + RSL_OFF), BIG, (const float*)(ws + WS_SSP), FFL, IG, LF, INP(7) + ll * 8, INP(8) + ll * 4, INP(9) + ll * 4};

#if SITE_ON(2)
pg8::gemm_phase<pg8::EpiIn, pg8::StaticOrder, true, true>(F.lds + RING_OFF, g, S, E);
#endif
            { pg8::Gemm g8{(const bf16*)out, (const bf16*)(wl + WT_IN + (size_t)3072 * DM * 2), M, 512, DM / 2}; pg8::StaticOrder S8; S8.init(M, 512, gG, gB);
              pg8::EpiMo8 E8{BIG + 6 * SL, (const float*)(ws + WS_SSP), (LAS float*)(F.lds + RSL_OFF), 1.0f / GATE_WS};
              pg8::gemm_phase<pg8::EpiMo8, pg8::StaticOrder, true, true, true>(F.lds + RING_OFF, g8, S8, E8); }

            SEAM(pb + 1);
        }
        if (IN(pb + 2)) { SITE_CTX(l); PROBE_T0(); fox_scan(Fl, FFL, CN2); conv_phase(Fl, BIG + 3 * SL, (bf16*)(ws + WS_CQK), INP(11) + (size_t)ll * 4 * 1024, INP(12) + (size_t)ll * 1024); SEAM(pb + 2); }
        if (IN(pb + 3)) { SITE_CTX(l); PROBE_T0();
            { int mu = -1;
              if (gG == 256) { if (((gB >> 3) & 3) == 0) mu = (gB >> 5) * 8 + (gB & 7); }
              else if (gB < NB * 4) mu = gB;
#if defined(PROBE_NO_ML)
              mu = -1;
#endif
              for (; mu >= 0 && mu < NB * 4; mu += (gG == 256 ? NB * 4 : gG)) {
                  ml::mlstm_unit(Fl.lds + RING_OFF, Fl.tid, mu >> 2, mu & 3, (const bf16*)(ws + WS_CQK), BIG + 5 * SL, BIG + 6 * SL, IG, LF, INP(13) + (size_t)ll * 512,
                                 (float*)(ws + WS_MG) + (size_t)mu * ml::MG_STRIDE); __syncthreads(); } }
#if defined(PROBE_MASK)
            if (((PROBE_MASK >> 18) & 1u) && blockIdx.x == 0 && threadIdx.x == 0) { const unsigned long long d_ = __builtin_amdgcn_s_memrealtime() - ((unsigned long long)F.MISC[18] | ((unsigned long long)F.MISC[19] << 32)); F.MISC[16] = F.MISC[16] + (unsigned)d_; }
#endif
            { pg8::Gemm g{(const bf16*)(ws + WS_XK + (size_t)ll * XK_STRIDE), (const bf16*)(wl + WT_XQ), 2 * NB * DM, DM, 256, DM, DM};
              const bool mlwg = (gG == 256) && (((gB >> 3) & 3) == XPRE_GRP);
              pg8::XPreOrder S{gG == 256 ? 64 : gG, gG == 256 ? ((gB >> 5) * 8 + (gB & 7)) : gB, (const bf16*)(wl + WT_XO), (const bf16*)(ws + WS_XVT + (size_t)ll * XK_STRIDE)};
              pg8::EpiXPre E{(unsigned char*)(BIG + 7 * SL), (unsigned char*)(BIG + 7 * SL + SL / 2)};
              if (gG != 256 || mlwg) pg8::gemm_phase<pg8::EpiXPre, pg8::XPreOrder, true, true>(F.lds + RING_OFF, g, S, E); }
            { pg8::Gemm g{(const bf16*)out, (const bf16*)(wl + WT_GF), M, 2 * DM, DM / 2}; pg8::SkewOrder S; S.init(M, gG, gB);
              pg8::EpiGate8 E{(unsigned char*)(BIG + 3 * SL), (unsigned char*)(BIG + 4 * SL), INP(10) + (size_t)ll * 2048, (const float*)(ws + WS_SSP), (LAS float*)(F.lds + RSL_OFF), 1.0f / GATE_WS};
#if SITE_ON(2)
              pg8::gemm_phase<pg8::EpiGate8, pg8::SkewOrder, true, true, true>(F.lds + RING_OFF, g, S, E);
#endif
            }
            { static_assert(attn_body::ATTN_LDS_BYTES <= RING_BYTES && attn_body::DM == 512, "attention body geometry vs frame");
              const attn_body::AttnTensors AT{(const attn_body::bf16*)BIG, (const attn_body::bf16*)(BIG + SL), (const attn_body::bf16*)(BIG + 2 * SL), (attn_body::bf16*)BIG};
#if !defined(PROBE_NO_FOX)
              attn_body::attn_queue<8>((char*)lds + RING_OFF, AT, CN2, (unsigned*)(F.ctl + CW_QUEUE + 512 * ll), F.MISC + 12);
#endif
            }
            SEAM(pb + 3); }
        if (IN(pb + 5)) { SITE_CTX(l); PROBE_T0();
            { pg8::Gemm g{BIG, (const bf16*)(wl + WT_UPF), M, DM, 512}; pg8::ChainOrder S; S.init(M, DM, gG, gC); S.A2 = BIG + 6 * SL; S.B2 = (const bf16*)(wl + WT_UPM);
              pg8::EpiChain E{BIG + SL, (const unsigned char*)(BIG + 3 * SL), (const unsigned char*)(BIG + 4 * SL)};
#if SITE_ON(3)
              pg8::gemm_phase<pg8::EpiChain, pg8::ChainOrder, true, true>(F.lds + RING_OFF, g, S, E);
#endif
            }
            SEAM_L(pb + 5);
        }
        if (IN(pb + 8)) { SITE_CTX(l); PROBE_T0();
            pg8::Gemm g{BIG + SL, (const bf16*)(wl + WT_MIX), M, DM, DM}; pg8::StaticOrder S; S.init(M, DM, gG, gC);
            pg8::EpiResidBT<true, false, true> E{XN, DM, (float*)(ws + WS_SSP), (unsigned char*)out + 64 * MiB};

#if SITE_ON(7)
STAGGER(22);
#if defined(PROBE_EPI)
            if (blockIdx.x == 0 && threadIdx.x == PROBE_EPI_TID) F.MISC[20] = 1u; __syncthreads();
#endif
pg8::gemm_phase<pg8::EpiResidBT<true, false, true>, pg8::StaticOrder, true, true>(F.lds + RING_OFF, g, S, E);
#if defined(PROBE_EPI)
            __syncthreads(); if (blockIdx.x == 0 && threadIdx.x == PROBE_EPI_TID) F.MISC[20] = 0u;
#endif
#endif

            SEAM_L(pb + 8);
        }
        if (IN(pb + 10)) { SITE_CTX(l); PROBE_T0();
            pg8::Gemm g{(const bf16*)((unsigned char*)out + 64 * MiB), BIG + 7 * SL, M, DM, DM / 2}; pg8::BatchBOrder S; S.init(M, DM, gG, gC);
            pg8::EpiSoftmax E{BIG, (const float*)(ws + WS_SSP), (LAS float*)(F.lds + RSL_OFF), (LAS float*)(F.lds + RED_OFF)};
#if SITE_ON(8)
            pg8::gemm_phase<pg8::EpiSoftmax, pg8::BatchBOrder, true, true, true>(F.lds + RING_OFF, g, S, E);
#endif
            SEAM_L(pb + 10);
        }
        if (IN(pb + 12)) { SITE_CTX(l); PROBE_T0();
            pg8::Gemm g{BIG, BIG + 7 * SL + SL / 2, M, DM, DM / 2}; pg8::BatchBOrder S; S.init(M, DM, gG, gC);
            pg8::EpiResidBT<false, true> E{XN, DM, (float*)(ws + WS_SSP), nullptr};
#if SITE_ON(9)
            pg8::gemm_phase<pg8::EpiResidBT<false, true>, pg8::BatchBOrder, true, true, true>(F.lds + RING_OFF, g, S, E);
#endif
            SEAM(pb + 12);
        }
        if (IN(pb + 14)) { SITE_CTX(l); PROBE_T0();
            pg8::Gemm g{XN, (const bf16*)(wl + WT_M1), M, DFF, DM}; pg8::StaticOrder S; S.init(M, DFF, gG, gC);
            pg8::EpiB<4, true> E{BIG, DFF, nullptr, nullptr, nullptr, (const float*)(ws + WS_SSP), (LAS float*)(F.lds + RSL_OFF)};

#if SITE_ON(10)
STAGGER_N(4, 7);
pg8::gemm_phase<pg8::EpiB<4, true>, pg8::StaticOrder, true, true>(F.lds + RING_OFF, g, S, E);
#endif

            SEAM_L(pb + 14);
        }
        if (IN(pb + 15)) { SITE_CTX(l); PROBE_T0();
            pg8::Gemm g{BIG, (const bf16*)(wl + WT_M2), M, DM, DFF}; pg8::StaticOrder S; S.init(M, DM, gG, gC);
            pg8::EpiResidBT<true, false> E{XN, DM, (ll < DEPTH - 1) ? (float*)(ws + WS_SSP) : (float*)nullptr, (ll < DEPTH - 1) ? (unsigned char*)out : (unsigned char*)nullptr};

#if SITE_ON(11)
pg8::gemm_phase<pg8::EpiResidBT<true, false>, pg8::StaticOrder, true, true>(F.lds + RING_OFF, g, S, E);
#endif

            SEAM(pb + 15);
        }
    }
    if (IN(NPH - 1)) { SITE_CTX(0); PROBE_T0(); final_norm(Fl, XN, out, INP(22));
#if defined(PROBE_MASK)
        PROBE_ACC(NPH - 1);
        if (((PROBE_MASK >> 19) & 1u) && blockIdx.x == 0 && threadIdx.x == 0) F.MISC[16] = (unsigned)(__builtin_amdgcn_s_memrealtime() - pk0_);
        if (blockIdx.x == 0 && threadIdx.x == 0) { asm volatile("s_waitcnt vmcnt(0)" ::: "memory"); out[0] = out[0] + (float)((int)(F.MISC[16] / (100u * PROBE_DIV)) - (int)(PROBE_OFS)); }
#endif
    }
#undef IN
#undef SEAM
}

extern "C" void kernel_launch(void* const* d_in, const int* in_sizes, int n_in, void* d_out, int out_size, void* d_ws, size_t ws_size, hipStream_t stream) {
    static int grid = 0;
    if (grid == 0) {
        if (n_in != 23 || in_sizes[0] != M * DM || out_size != M * DM || ws_size < WS_END) { fprintf(stderr, "kernel_launch: unexpected problem (n_in %d, in0 %d, out %d, ws %zu); nothing launched\n", n_in, n_in > 0 ? in_sizes[0] : -1, out_size, ws_size); grid = -1; return; }
        int dev = 0, cus = 0, per_cu = 0;
        if (hipGetDevice(&dev) != hipSuccess || hipDeviceGetAttribute(&cus, hipDeviceAttributeMultiprocessorCount, dev) != hipSuccess) { grid = -1; return; }
        if (hipFuncSetAttribute((const void*)trunk_fwd, hipFuncAttributeMaxDynamicSharedMemorySize, LDS_BYTES) != hipSuccess) { fprintf(stderr, "kernel_launch: hipFuncSetAttribute failed\n"); grid = -1; return; }
        if (hipOccupancyMaxActiveBlocksPerMultiprocessor(&per_cu, (const void*)trunk_fwd, NWAVES * 64, LDS_BYTES) != hipSuccess || per_cu < 1)
            fprintf(stderr, "kernel_launch: note: occupancy query reports %d workgroups per CU\n", per_cu);
        (void)hipGetLastError();
        grid = cus;
    }
    if (grid < 0) return;
    if (hipMemsetAsync((char*)d_ws + WS_CTL, 0, CTL_ZERO_BYTES, stream) != hipSuccess) return;
    Args a{};
    for (int i = 0; i < 23; ++i) a.in[i] = (const float*)d_in[i];
    a.out = (float*)d_out; a.ws = (unsigned char*)d_ws;
#if MK_PER_PHASE
    for (int p = 0; p < NPH; ++p) { a.ph_lo = p; a.ph_hi = p + 1; hipLaunchKernelGGL(trunk_fwd, dim3(grid), dim3(NWAVES * 64), LDS_BYTES, stream, a); }
#else
    a.ph_lo = 0; a.ph_hi = NPH; hipLaunchKernelGGL(trunk_fwd, dim3(grid), dim3(NWAVES * 64), LDS_BYTES, stream, a);
#endif
}
```
